# Optimizing an MI355X kernel written in HIP

```python
import math
import jax
import jax.numpy as jnp
from jax import lax
import numpy as np

D_MODEL = 1024
BATCH = 16
SEQ = 256
DEPTH = 2
DEC_BATCH = 4
DEC_SEQ = 4096
PAST_LEN = 512

GRID_W = 64
N_HEADS = 16
HEAD_DIM = D_MODEL // N_HEADS
D_RNN = D_MODEL // 2
RNN_HEADS = 8
RNN_BLOCK = D_RNN // RNN_HEADS
CONV_W = 4
D_FOURIER = D_MODEL // 2
FOURIER_GROUPS = 4
FOURIER_CH = D_FOURIER // FOURIER_GROUPS
D_IN_EVEN = 2 * D_RNN + D_FOURIER
D_OUT_EVEN = D_RNN + D_FOURIER
D_FF = 4 * D_MODEL
NA_ROWS = 8
NA_COLS = 16
C_SCALE = 8.0
N_EVEN = (DEPTH + 1) // 2
N_ODD = DEPTH // 2
ALPHA = (2 * DEPTH) ** 0.25
BETA = (8 * DEPTH) ** -0.25
LN_EPS = 1e-5

kernel_name = "hybrid_diffusion_rglru_fnet_natten_step"


def layer_norm(x, g=None, b=None):
    xf = x.astype(jnp.float32)
    mu = jnp.mean(xf, axis=-1, keepdims=True)
    var = jnp.mean(jnp.square(xf - mu), axis=-1, keepdims=True)
    y = (xf - mu) * lax.rsqrt(var + LN_EPS)
    if g is not None:
        y = y * g.astype(jnp.float32) + b.astype(jnp.float32)
    return y.astype(x.dtype)


def ada_params(cond, w, b):
    m = jax.nn.silu(cond) @ w + b
    return jnp.split(m[..., None, :], 6, axis=-1)


def modulate(x, shift, scale):
    return layer_norm(x) * (1.0 + scale) + shift


def depthwise_conv(x, w, b):
    S = x.shape[1]
    left = CONV_W // 2
    xp = jnp.pad(x, ((0, 0), (left, CONV_W - 1 - left), (0, 0)))
    out = b
    for k in range(CONV_W):
        out = out + xp[:, k:k + S] * w[k]
    return out


def block_diag(x, w, b):
    xb = x.reshape(x.shape[:-1] + (RNN_HEADS, RNN_BLOCK))
    y = jnp.einsum('bshi,hij->bshj', xb, w.astype(x.dtype))
    return y.reshape(x.shape) + b.astype(x.dtype)


def _lin_combine(e1, e2):
    a1, b1 = e1
    a2, b2 = e2
    return a1 * a2, a2 * b1 + b2


def rglru(xc, w_r, b_r, w_i, b_i, lam, h0, reverse):
    xf = xc.astype(jnp.float32)
    r = jax.nn.sigmoid(block_diag(xf, w_r, b_r))
    i = jax.nn.sigmoid(block_diag(xf, w_i, b_i))
    log_a = -C_SCALE * r * jax.nn.softplus(-lam.astype(jnp.float32))
    a = jnp.exp(log_a)
    bterm = jnp.sqrt(-jnp.expm1(2.0 * log_a)) * (i * xf)
    h0f = h0.astype(jnp.float32)
    if reverse:
        bterm = bterm.at[:, -1].add(a[:, -1] * h0f)
    else:
        bterm = bterm.at[:, 0].add(a[:, 0] * h0f)
    _, h = lax.associative_scan(_lin_combine, (a, bterm), reverse=reverse, axis=1)
    return h.astype(xc.dtype)


def fourier_mix(xf):
    B, S, _ = xf.shape
    z = xf.reshape(B, S, FOURIER_GROUPS, FOURIER_CH).astype(jnp.float32)
    z = jnp.fft.fft2(z, axes=(1, 3), norm='ortho').real
    return z.reshape(B, S, D_FOURIER).astype(xf.dtype)


def mix_even(h, h0, w_in, b_in, conv_w, conv_b, w_r, b_r, w_i, b_i, lam, w_out, b_out):
    u = h @ w_in + b_in
    x_rnn = u[..., :D_RNN]
    x_gate = u[..., D_RNN:2 * D_RNN]
    x_four = u[..., 2 * D_RNN:]
    xc = depthwise_conv(x_rnn, conv_w, conv_b)
    h_fwd = rglru(xc, w_r[0], b_r[0], w_i[0], b_i[0], lam[0], h0[:, 0], reverse=False)
    h_bwd = rglru(xc, w_r[1], b_r[1], w_i[1], b_i[1], lam[1], h0[:, 1], reverse=True)
    y_a = (h_fwd + h_bwd) * jax.nn.gelu(x_gate)
    y_b = fourier_mix(x_four)
    y = jnp.concatenate([y_a, y_b], axis=-1) @ w_out + b_out
    final_state = jnp.stack([h_fwd[:, -1], h_bwd[:, 0]], axis=1)
    return y, final_state


def split_heads(t):
    B, S, _ = t.shape
    return t.reshape(B, S, N_HEADS, HEAD_DIM).transpose(0, 2, 1, 3)


def attn_context(h, w_qkv, b_qkv, w_out, b_out):
    B, S, _ = h.shape
    qkv = h @ w_qkv + b_qkv
    q, k, v = (split_heads(t) for t in jnp.split(qkv, 3, axis=-1))
    s = jnp.einsum('bhqd,bhkd->bhqk', q, k).astype(jnp.float32) * (HEAD_DIM ** -0.5)
    p = jax.nn.softmax(s, axis=-1).astype(v.dtype)
    o = jnp.einsum('bhqk,bhkd->bhqd', p, v)
    o = o.transpose(0, 2, 1, 3).reshape(B, S, D_MODEL)
    return o @ w_out + b_out, k, v


def attn_latent(h, k_ctx, v_ctx, w_qkv, b_qkv, rpb, w_out, b_out):
    B, N, _ = h.shape
    rows = N // GRID_W
    kr = min(NA_ROWS, rows)
    qkv = h @ w_qkv + b_qkv
    q, k, v = (split_heads(t).reshape(B, N_HEADS, rows, GRID_W, HEAD_DIM)
               for t in jnp.split(qkv, 3, axis=-1))
    col = jnp.arange(GRID_W)
    col_start = jnp.clip(col - NA_COLS // 2, 0, GRID_W - NA_COLS)
    col_mask = (col[None, :] >= col_start[:, None]) & (col[None, :] < col_start[:, None] + NA_COLS)
    col_off = jnp.clip(col[None, :] - col[:, None] + NA_COLS - 1, 0, 2 * NA_COLS - 2)
    scale = HEAD_DIM ** -0.5
    s_ctx_all = None

    def row_block(i):
        rs = jnp.clip(i - kr // 2, 0, rows - kr)
        q_i = lax.dynamic_index_in_dim(q, i, axis=2, keepdims=False)
        k_blk = lax.dynamic_slice_in_dim(k, rs, kr, axis=2)
        v_blk = lax.dynamic_slice_in_dim(v, rs, kr, axis=2)
        s_loc = jnp.einsum('bhqd,bhakd->bhqak', q_i, k_blk).astype(jnp.float32) * scale
        row_off = rs + jnp.arange(kr) - i + NA_ROWS - 1
        bias = rpb[:, row_off][:, :, col_off].astype(jnp.float32)
        bias = bias.transpose(0, 2, 1, 3)
        s_loc = jnp.where(col_mask[:, None, :], s_loc + bias, -jnp.inf)
        s_ctx = jnp.einsum('bhqd,bhcd->bhqc', q_i, k_ctx).astype(jnp.float32) * scale
        logits = jnp.concatenate([s_loc.reshape(B, N_HEADS, GRID_W, kr * GRID_W), s_ctx], axis=-1)
        p = jax.nn.softmax(logits, axis=-1)
        p_loc = p[..., :kr * GRID_W].reshape(B, N_HEADS, GRID_W, kr, GRID_W).astype(v.dtype)
        p_ctx = p[..., kr * GRID_W:].astype(v.dtype)
        return (jnp.einsum('bhqak,bhakd->bhqd', p_loc, v_blk)
                + jnp.einsum('bhqc,bhcd->bhqd', p_ctx, v_ctx))

    o = lax.map(row_block, jnp.arange(rows))
    o = o.transpose(1, 0, 3, 2, 4).reshape(B, N, D_MODEL)
    return o @ w_out + b_out


def mlp(h, w1, b1, w2, b2):
    return jnp.square(jax.nn.relu(h @ w1 + b1)) @ w2 + b2


def setup_inputs(seed: int = 0) -> dict:
    key = jax.random.key(seed)
    ks = iter(jax.random.split(key, 40))
    f32 = jnp.float32

    def nrm(shape, s):
        return jax.random.normal(next(ks), shape, f32) * s

    inp = {}
    inp['x_prompt'] = nrm((BATCH, SEQ, D_MODEL), 1.0)
    inp['x_sample'] = nrm((DEC_BATCH, DEC_SEQ, D_MODEL), 1.0)
    inp['c'] = nrm((DEC_BATCH, D_MODEL), 1.0)
    inp['state_lru'] = nrm((DEC_BATCH, N_EVEN, 2, D_RNN), 0.5)
    inp['cache_k'] = nrm((DEC_BATCH, N_ODD, N_HEADS, PAST_LEN, HEAD_DIM), 1.0)
    inp['cache_v'] = nrm((DEC_BATCH, N_ODD, N_HEADS, PAST_LEN, HEAD_DIM), 1.0)
    inp['c_ctx'] = nrm((D_MODEL,), 1.0)
    inp['ada_w'] = nrm((DEPTH, D_MODEL, 6 * D_MODEL), 0.5 * D_MODEL ** -0.5)
    inp['ada_b'] = nrm((DEPTH, 6 * D_MODEL), 0.02)
    inp['ln1_g'] = 1.0 + nrm((DEPTH, D_MODEL), 0.02)
    inp['ln1_b'] = nrm((DEPTH, D_MODEL), 0.02)
    inp['ln2_g'] = 1.0 + nrm((DEPTH, D_MODEL), 0.02)
    inp['ln2_b'] = nrm((DEPTH, D_MODEL), 0.02)
    inp['w1'] = nrm((DEPTH, D_MODEL, D_FF), D_MODEL ** -0.5)
    inp['b1'] = nrm((DEPTH, D_FF), 0.02)
    inp['w2'] = nrm((DEPTH, D_FF, D_MODEL), BETA * D_FF ** -0.5)
    inp['b2'] = nrm((DEPTH, D_MODEL), 0.02)
    inp['e_w_in'] = nrm((N_EVEN, D_MODEL, D_IN_EVEN), D_MODEL ** -0.5)
    inp['e_b_in'] = nrm((N_EVEN, D_IN_EVEN), 0.02)
    inp['e_conv_w'] = nrm((N_EVEN, CONV_W, D_RNN), CONV_W ** -0.5)
    inp['e_conv_b'] = nrm((N_EVEN, D_RNN), 0.02)
    inp['e_w_r'] = nrm((N_EVEN, 2, RNN_HEADS, RNN_BLOCK, RNN_BLOCK), RNN_BLOCK ** -0.5)
    inp['e_b_r'] = nrm((N_EVEN, 2, D_RNN), 0.02)
    inp['e_w_i'] = nrm((N_EVEN, 2, RNN_HEADS, RNN_BLOCK, RNN_BLOCK), RNN_BLOCK ** -0.5)
    inp['e_b_i'] = nrm((N_EVEN, 2, D_RNN), 0.02)
    a0 = jax.random.uniform(next(ks), (N_EVEN, 2, D_RNN), f32, 0.9, 0.999)
    a_root = a0 ** (1.0 / C_SCALE)
    inp['e_lam'] = jnp.log(a_root) - jnp.log1p(-a_root)
    inp['e_w_out'] = nrm((N_EVEN, D_OUT_EVEN, D_MODEL), BETA * D_OUT_EVEN ** -0.5)
    inp['e_b_out'] = nrm((N_EVEN, D_MODEL), 0.02)
    inp['o_w_qkv'] = nrm((N_ODD, D_MODEL, 3 * D_MODEL), D_MODEL ** -0.5)
    inp['o_b_qkv'] = nrm((N_ODD, 3 * D_MODEL), 0.02)
    inp['o_rpb'] = nrm((N_ODD, N_HEADS, 2 * NA_ROWS - 1, 2 * NA_COLS - 1), 0.1)
    inp['o_w_out'] = nrm((N_ODD, D_MODEL, D_MODEL), BETA * D_MODEL ** -0.5)
    inp['o_b_out'] = nrm((N_ODD, D_MODEL), 0.02)
    return inp


def reference(x_prompt, x_sample, c, state_lru, cache_k, cache_v, c_ctx,
              ada_w, ada_b, ln1_g, ln1_b, ln2_g, ln2_b, w1, b1, w2, b2,
              e_w_in, e_b_in, e_conv_w, e_conv_b, e_w_r, e_b_r, e_w_i, e_b_i, e_lam,
              e_w_out, e_b_out, o_w_qkv, o_b_qkv, o_rpb, o_w_out, o_b_out):
    xp = x_prompt
    xs = x_sample
    new_lru = []
    new_k = []
    new_v = []
    for layer in range(DEPTH):
        mp = ada_params(c_ctx, ada_w[layer], ada_b[layer])
        ms = ada_params(c, ada_w[layer], ada_b[layer])
        hp = modulate(xp, mp[0], mp[1])
        hs = modulate(xs, ms[0], ms[1])
        if layer % 2 == 0:
            j = layer // 2
            prm = (e_w_in[j], e_b_in[j], e_conv_w[j], e_conv_b[j], e_w_r[j], e_b_r[j],
                   e_w_i[j], e_b_i[j], e_lam[j], e_w_out[j], e_b_out[j])
            h0_ctx = jnp.zeros((xp.shape[0], 2, D_RNN), xp.dtype)
            yp, st_ctx = mix_even(hp, h0_ctx, *prm)
            ys, _ = mix_even(hs, state_lru[:, j], *prm)
            new_lru.append(st_ctx)
        else:
            j = layer // 2
            yp, k_ctx, v_ctx = attn_context(hp, o_w_qkv[j], o_b_qkv[j], o_w_out[j], o_b_out[j])
            ys = attn_latent(hs, cache_k[:, j], cache_v[:, j], o_w_qkv[j], o_b_qkv[j],
                             o_rpb[j], o_w_out[j], o_b_out[j])
            new_k.append(k_ctx)
            new_v.append(v_ctx)
        xp = layer_norm(ALPHA * xp + mp[2] * yp, ln1_g[layer], ln1_b[layer])
        xs = layer_norm(ALPHA * xs + ms[2] * ys, ln1_g[layer], ln1_b[layer])
        hp = modulate(xp, mp[3], mp[4])
        hs = modulate(xs, ms[3], ms[4])
        xp = layer_norm(ALPHA * xp + mp[5] * mlp(hp, w1[layer], b1[layer], w2[layer], b2[layer]),
                        ln2_g[layer], ln2_b[layer])
        xs = layer_norm(ALPHA * xs + ms[5] * mlp(hs, w1[layer], b1[layer], w2[layer], b2[layer]),
                        ln2_g[layer], ln2_b[layer])
    new_state_lru = jnp.stack(new_lru, axis=1)
    new_cache_k = jnp.stack(new_k, axis=1)
    new_cache_v = jnp.stack(new_v, axis=1)
    return (xp, xs, new_state_lru, new_cache_k, new_cache_v)
```

```cpp
#include <hip/hip_runtime.h>
#include <hip/hip_cooperative_groups.h>
#include <cstdio>
namespace cg = cooperative_groups;

typedef _Float16 f16;
typedef __attribute__((ext_vector_type(8))) _Float16 f16x8;
typedef __attribute__((ext_vector_type(4))) _Float16 f16x4;
typedef __attribute__((ext_vector_type(16))) float f32x16;
#define DI __device__ __forceinline__
#define LAS __attribute__((address_space(3)))
#define MFMA(a, b, c) __builtin_amdgcn_mfma_f32_32x32x16_f16((a), (b), (c), 0, 0, 0)

constexpr int T = 20480;
constexpr int TP = 4096;
constexpr int TH = 10240;
constexpr float ALPHA = 1.41421356237f;
constexpr float LOG2E = 1.4426950408889634f;
constexpr float QSCALE = 0.125f * LOG2E;
constexpr int kLds = 147456;
#define REP_PHASE -1

constexpr size_t WS_WIN = 0;
constexpr size_t WS_WOUT0 = WS_WIN + 1536ull * 1024 * 2;
constexpr size_t WS_W1 = WS_WOUT0 + 1024ull * 1024 * 2;
constexpr size_t WS_W2 = WS_W1 + 2ull * 4096 * 1024 * 2;
constexpr size_t WS_WQKV = WS_W2 + 2ull * 4096 * 1024 * 2;
constexpr size_t WS_WO1 = WS_WQKV + 3072ull * 1024 * 2;
constexpr size_t WS_GW = WS_WO1 + 1024ull * 1024 * 2;
constexpr size_t WS_FC = WS_GW + 32ull * 4096 * 2;
constexpr size_t WS_D256 = WS_FC + 256ull * 128 * 2;
constexpr size_t WS_F64 = WS_D256 + 256ull * 512 * 2;
constexpr size_t WS_DS = WS_F64 + 128ull * 128 * 2;
constexpr size_t WS_ADAP = WS_DS + 4096ull * 128 * 2;
constexpr size_t WS_SUM = WS_ADAP + 2ull * 4 * 5 * 6144 * 4;
constexpr size_t WS_XR = WS_SUM + 320ull * 2 * 512 * 8;
constexpr size_t WS_H = WS_XR + (size_t)T * 1024 * 4;
constexpr size_t WS_B1 = WS_H + (size_t)T * 1024 * 2;
constexpr size_t WS_BAR = WS_B1 + (size_t)T * 1024 * 4;
constexpr size_t WS_ADAF = WS_BAR + 3456 * 4;
constexpr size_t WS_END = WS_ADAF + 2ull * 5 * 6144 * 4;
constexpr size_t B2_W1C = 0;
constexpr size_t B2_W1L = 8388608;
constexpr size_t B2_Z = 41943040;
constexpr size_t B2_VTC = 0;
constexpr size_t B2_VTL = 8388608;
constexpr size_t B2_CK = 41943040;
constexpr size_t B2_CVT = 46137344;
constexpr size_t OUT_LRU = (size_t)T * 1024;
constexpr size_t OUT_NK = OUT_LRU + 16 * 2 * 512;
constexpr size_t OUT_NV = OUT_NK + 16ull * 16 * 256 * 64;

struct Params {
  const float *x_prompt, *x_sample, *c, *state_lru, *cache_k, *cache_v, *c_ctx, *ada_w, *ada_b, *ln1_g, *ln1_b, *ln2_g,
      *ln2_b, *w1, *b1, *w2, *b2, *e_w_in, *e_b_in, *e_conv_w, *e_conv_b, *e_w_r, *e_b_r, *e_w_i, *e_b_i, *e_lam,
      *e_w_out, *e_b_out, *o_w_qkv, *o_b_qkv, *o_rpb, *o_w_out, *o_b_out;
  float* out;
  char* ws;
  int phase_lo, phase_hi;
};

typedef const __attribute__((address_space(4))) Params* KP;
DI int tidf_() { int t = threadIdx.x; asm volatile("" : "+v"(t)); return t; }
DI int tid_() { return tidf_() & 255; }
DI int half_() { return __builtin_amdgcn_readfirstlane((int)(threadIdx.x >> 8)); }
constexpr int kHalfLds = 73728;
DI int crow(int reg, int hh) { return (reg & 3) + 8 * (reg >> 2) + 4 * hh; }
DI float wave_sum(float v) {
#pragma unroll
  for (int o = 32; o; o >>= 1) v += __shfl_xor(v, o);
  return v;
}
DI float sigmoidf_(float x) { return __builtin_amdgcn_rcpf(1.f + __expf(-x)); }
DI float one_minus_exp(float x) {
  const float p = -x * (1.f + x * (0.5f + x * (0.16666667f + x * (0.041666668f + x * (0.0083333338f + x * 0.0013888889f)))));
  return x > -0.25f ? p : 1.f - __expf(x);
}
DI float ada_val(KP P, int layer, int cond, int idx) {
  const float* adap = (const float*)(P->ws + WS_ADAP);
  float s = P->ada_b[layer * 6144 + idx];
#pragma unroll
  for (int kc = 0; kc < 4; ++kc) s += adap[((layer * 4 + kc) * 5 + cond) * 6144 + idx];
  return s;
}
DI float adaf(KP P, int layer, int cond, int idx) { return ((const float*)(P->ws + WS_ADAF))[(layer * 5 + cond) * 6144 + idx]; }
DI int cond_of(int t) { return t < TP ? 0 : 1 + ((t - TP) >> 12); }

template <bool TR = false, int VAR = 0, class AF, class BF, class EF>
DI void gemm_tile(char* smem, int K, AF arow, BF brow, EF epi) {
  const int tid = tid_(), lane = tid & 63, wave = tid >> 6;
  const int wm = wave >> 1, wn = wave & 1, l32 = lane & 31, hh = lane >> 5;
  const int lr = lane >> 2, lc = ((lane & 3) ^ ((lane >> 4) & 3)) * 8;
  const f16* ap0 = arow(wave * 64 + lr) + lc;
  const f16* ap1 = arow(wave * 64 + 16 + lr) + lc;
  const f16* ap2 = arow(wave * 64 + 32 + lr) + lc;
  const f16* ap3 = arow(wave * 64 + 48 + lr) + lc;
  const f16* bp0 = brow(wave * 32 + lr) + lc;
  const f16* bp1 = brow(wave * 32 + 16 + lr) + lc;
  const int dA = wave * 4096 + lane * 16, dB = 16384 + wave * 2048 + lane * 16;
#define DMA(stage_off, ko)                                                                                       \
  __builtin_amdgcn_global_load_lds((const void*)(ap0 + (ko)), (LAS void*)(smem + (stage_off) + dA), 16, 0, 0);          \
  __builtin_amdgcn_global_load_lds((const void*)(ap1 + (ko)), (LAS void*)(smem + (stage_off) + dA + 1024), 16, 0, 0);   \
  __builtin_amdgcn_global_load_lds((const void*)(ap2 + (ko)), (LAS void*)(smem + (stage_off) + dA + 2048), 16, 0, 0);   \
  __builtin_amdgcn_global_load_lds((const void*)(ap3 + (ko)), (LAS void*)(smem + (stage_off) + dA + 3072), 16, 0, 0);   \
  __builtin_amdgcn_global_load_lds((const void*)(bp0 + (ko)), (LAS void*)(smem + (stage_off) + dB), 16, 0, 0);          \
  __builtin_amdgcn_global_load_lds((const void*)(bp1 + (ko)), (LAS void*)(smem + (stage_off) + dB + 1024), 16, 0, 0);
  const int nk = K >> 5;
  DMA(0, 0)
  DMA(24576, 32)
  asm volatile("s_waitcnt vmcnt(6)" ::: "memory");
  __builtin_amdgcn_s_barrier();
  f32x16 acc[4][2];
#pragma unroll
  for (int i = 0; i < 4; ++i)
#pragma unroll
    for (int j = 0; j < 2; ++j)
#pragma unroll
      for (int e = 0; e < 16; ++e) acc[i][j][e] = 0.f;
  const int rsw = (l32 >> 2) & 3;
  const int aoff = (wm * 128 + l32) * 64, boff = 16384 + (wn * 64 + l32) * 64;
  int cur = 0, nxt = 49152;
  for (int kt = 0; kt < nk; ++kt) {
    if (kt + 2 < nk) { const int kk = kt + 2; DMA(nxt, (VAR == 1 ? 0 : VAR == 3 ? ((((kk >> 1) ^ lr) << 6) + (kk & 1) * 32) : kk * 32)) }
    const char* st = smem + cur;
    {
      const int co0 = ((0 + hh) ^ rsw) << 4, co1 = ((2 + hh) ^ rsw) << 4;
      f16x8 a0[4], b0[2], a1[4], b1[2];
#pragma unroll
      for (int j = 0; j < 2; ++j) b0[j] = *(const f16x8*)(st + boff + j * 2048 + co0);
#pragma unroll
      for (int i = 0; i < 4; ++i) a0[i] = *(const f16x8*)(st + aoff + i * 2048 + co0);
#pragma unroll
      for (int j = 0; j < 2; ++j) b1[j] = *(const f16x8*)(st + boff + j * 2048 + co1);
#pragma unroll
      for (int i = 0; i < 4; ++i) a1[i] = *(const f16x8*)(st + aoff + i * 2048 + co1);
      __builtin_amdgcn_sched_barrier(0);
      if (VAR == 2) { acc[0][0][0] += (float)a0[0][0] + (float)b0[0][0] + (float)a1[3][0] + (float)b1[1][0]; } else {
#pragma unroll
      for (int i = 0; i < 4; ++i)
#pragma unroll
        for (int j = 0; j < 2; ++j) acc[i][j] = TR ? MFMA(b0[j], a0[i], acc[i][j]) : MFMA(a0[i], b0[j], acc[i][j]);
#pragma unroll
      for (int i = 0; i < 4; ++i)
#pragma unroll
        for (int j = 0; j < 2; ++j) acc[i][j] = TR ? MFMA(b1[j], a1[i], acc[i][j]) : MFMA(a1[i], b1[j], acc[i][j]);
      }
      __builtin_amdgcn_sched_barrier(0);
    }
    if (kt + 2 < nk) asm volatile("s_waitcnt vmcnt(6)" ::: "memory");
    else asm volatile("s_waitcnt vmcnt(0)" ::: "memory");
    __builtin_amdgcn_s_barrier();
    cur = cur == 49152 ? 0 : cur + 24576;
    nxt = nxt == 49152 ? 0 : nxt + 24576;
  }
#undef DMA
#pragma unroll
  for (int i = 0; i < 4; ++i)
#pragma unroll
    for (int j = 0; j < 2; ++j)
#pragma unroll
      for (int q = 0; q < 4; ++q)
        if (TR) epi(wm * 128 + i * 32 + l32, wn * 64 + j * 32 + 8 * q + 4 * hh, acc[i][j][4 * q], acc[i][j][4 * q + 1], acc[i][j][4 * q + 2], acc[i][j][4 * q + 3]);
        else epi(wm * 128 + i * 32 + 8 * q + 4 * hh, wn * 64 + j * 32 + l32, acc[i][j][4 * q], acc[i][j][4 * q + 1], acc[i][j][4 * q + 2], acc[i][j][4 * q + 3]);
}

template <int BN, bool TR, bool PK = false, class AF, class BF, class EF, class RF = int>
DI void gemm8w(char* smem, int K, AF arow, BF brow, EF epi, RF rowptr = 0) {
  constexpr int WN = BN / 64, WM = 8 / WN, MI = 256 / (WM * 32), NB = BN / 128;
  constexpr int STG = 16384 + BN * 64;
  const int tid = tidf_(), lane = tid & 63, wave = tid >> 6;
  const int grp = __builtin_amdgcn_readfirstlane(wave >> 2);
  const int wm = wave / WN, wn = wave % WN, l32 = lane & 31, hh = lane >> 5;
  const int lr = lane >> 2, lc = ((lane & 3) ^ ((lane >> 4) & 3)) * 8;
  const f16* ap0 = arow(wave * 32 + lr) + lc;
  const f16* ap1 = arow(wave * 32 + 16 + lr) + lc;
  const f16* bp0 = brow(wave * (16 * NB) + lr) + lc;
  const f16* bp1 = NB == 2 ? brow(wave * 32 + 16 + lr) + lc : bp0;
  const int dA = wave * 2048 + lane * 16, dB = 16384 + wave * (1024 * NB) + lane * 16;
#define DMA4(stage_off, ko)                                                                                              \
  __builtin_amdgcn_global_load_lds((const void*)(ap0 + (ko)), (LAS void*)(smem + (stage_off) + dA), 16, 0, 0);          \
  __builtin_amdgcn_global_load_lds((const void*)(ap1 + (ko)), (LAS void*)(smem + (stage_off) + dA + 1024), 16, 0, 0);   \
  __builtin_amdgcn_global_load_lds((const void*)(bp0 + (ko)), (LAS void*)(smem + (stage_off) + dB), 16, 0, 0);          \
  if (NB == 2) __builtin_amdgcn_global_load_lds((const void*)(bp1 + (ko)), (LAS void*)(smem + (stage_off) + dB + 1024), 16, 0, 0);
  const int nk = K >> 5;
  DMA4(0, 0)
  DMA4(STG, 32)
  DMA4(2 * STG, 64)
  if (NB == 2) asm volatile("s_waitcnt vmcnt(8)" ::: "memory"); else asm volatile("s_waitcnt vmcnt(6)" ::: "memory");
  __builtin_amdgcn_s_barrier();
  if (grp == 1) __builtin_amdgcn_s_barrier();
  f32x16 acc[MI][2];
#pragma unroll
  for (int i = 0; i < MI; ++i)
#pragma unroll
    for (int j = 0; j < 2; ++j)
#pragma unroll
      for (int e = 0; e < 16; ++e) acc[i][j][e] = 0.f;
  const int rsw = (l32 >> 2) & 3;
  const int aoff = (wm * (MI * 32) + l32) * 64, boff = 16384 + (wn * 64 + l32) * 64;
  const int co0 = ((0 + hh) ^ rsw) << 4, co1 = ((2 + hh) ^ rsw) << 4;
  int cur = 0, nxt = 3 * STG;
  for (int kt = 0; kt < nk; ++kt) {
    if (kt + 3 < nk) { DMA4(nxt, (kt + 3) * 32) }
    const char* st = smem + cur;
    f16x8 a0[MI], b0[2], a1[MI], b1[2];
#pragma unroll
    for (int j = 0; j < 2; ++j) b0[j] = *(const f16x8*)(st + boff + j * 2048 + co0);
#pragma unroll
    for (int i = 0; i < MI; ++i) a0[i] = *(const f16x8*)(st + aoff + i * 2048 + co0);
#pragma unroll
    for (int j = 0; j < 2; ++j) b1[j] = *(const f16x8*)(st + boff + j * 2048 + co1);
#pragma unroll
    for (int i = 0; i < MI; ++i) a1[i] = *(const f16x8*)(st + aoff + i * 2048 + co1);
    __builtin_amdgcn_sched_barrier(0);
    if (kt + 3 < nk) {
      if (NB == 2) asm volatile("s_waitcnt vmcnt(8) lgkmcnt(0)" ::: "memory"); else asm volatile("s_waitcnt vmcnt(6) lgkmcnt(0)" ::: "memory");
    } else {
      asm volatile("s_waitcnt vmcnt(0) lgkmcnt(0)" ::: "memory");
    }
    __builtin_amdgcn_s_barrier();
    __builtin_amdgcn_sched_barrier(0);
#pragma unroll
    for (int i = 0; i < MI; ++i)
#pragma unroll
      for (int j = 0; j < 2; ++j) acc[i][j] = TR ? MFMA(b0[j], a0[i], acc[i][j]) : MFMA(a0[i], b0[j], acc[i][j]);
#pragma unroll
    for (int i = 0; i < MI; ++i)
#pragma unroll
      for (int j = 0; j < 2; ++j) acc[i][j] = TR ? MFMA(b1[j], a1[i], acc[i][j]) : MFMA(a1[i], b1[j], acc[i][j]);
    __builtin_amdgcn_sched_barrier(0);
    __builtin_amdgcn_s_barrier();
    __builtin_amdgcn_sched_barrier(0);
    cur = cur == 3 * STG ? 0 : cur + STG;
    nxt = nxt == 3 * STG ? 0 : nxt + STG;
  }
  if (grp == 0) __builtin_amdgcn_s_barrier();
#undef DMA4
  if constexpr (PK) {
#pragma unroll
    for (int i = 0; i < MI; ++i)
#pragma unroll
      for (int j = 0; j < 2; ++j)
#pragma unroll
        for (int q = 0; q < 4; q += 2) {
          const int m = wm * (MI * 32) + i * 32 + l32, n = wn * 64 + j * 32 + 8 * q;
          const uint2 pa = epi(m, n + 4 * hh, acc[i][j][4 * q], acc[i][j][4 * q + 1], acc[i][j][4 * q + 2], acc[i][j][4 * q + 3]);
          const uint2 pb = epi(m, n + 8 + 4 * hh, acc[i][j][4 * q + 4], acc[i][j][4 * q + 5], acc[i][j][4 * q + 6], acc[i][j][4 * q + 7]);
          store_pair16(rowptr(m) + n, pa, pb, hh);
        }
  } else
#pragma unroll
  for (int i = 0; i < MI; ++i)
#pragma unroll
    for (int j = 0; j < 2; ++j)
#pragma unroll
      for (int q = 0; q < 4; ++q)
        if (TR) epi(wm * (MI * 32) + i * 32 + l32, wn * 64 + j * 32 + 8 * q + 4 * hh, acc[i][j][4 * q], acc[i][j][4 * q + 1], acc[i][j][4 * q + 2], acc[i][j][4 * q + 3]);
        else epi(wm * (MI * 32) + i * 32 + 8 * q + 4 * hh, wn * 64 + j * 32 + l32, acc[i][j][4 * q], acc[i][j][4 * q + 1], acc[i][j][4 * q + 2], acc[i][j][4 * q + 3]);
}

template <class AF, class BF, class EF, class RF>
DI void gemm8w_n128(char* smem, int K, AF arow, BF brow, EF epi, RF rowptr) {
  constexpr int STG = 24576;
  const int tid = tidf_(), lane = tid & 63, wave = tid >> 6;
  const int grp = __builtin_amdgcn_readfirstlane(wave >> 2);
  const int wm = wave >> 1, wn = wave & 1, l32 = lane & 31, hh = lane >> 5;
  const int lr = lane >> 2, lc = ((lane & 3) ^ ((lane >> 4) & 3)) * 8;
  const f16* ap0 = arow(wave * 32 + lr) + lc;
  const f16* ap1 = arow(wave * 32 + 16 + lr) + lc;
  const f16* bp0 = brow(wave * 16 + lr) + lc;
  const int dA = wave * 2048 + lane * 16, dB = 16384 + wave * 1024 + lane * 16;
#define DMA3(stage_off, ko)                                                                                              \
  __builtin_amdgcn_global_load_lds((const void*)(ap0 + (ko)), (LAS void*)(smem + (stage_off) + dA), 16, 0, 0);          \
  __builtin_amdgcn_global_load_lds((const void*)(ap1 + (ko)), (LAS void*)(smem + (stage_off) + dA + 1024), 16, 0, 0);   \
  __builtin_amdgcn_global_load_lds((const void*)(bp0 + (ko)), (LAS void*)(smem + (stage_off) + dB), 16, 0, 0);
  const int nk = K >> 5;
  DMA3(0, 0)
  DMA3(STG, 32)
  DMA3(2 * STG, 64)
  DMA3(3 * STG, 96)
  asm volatile("s_waitcnt vmcnt(6)" ::: "memory");
  __builtin_amdgcn_s_barrier();
  if (grp == 1) __builtin_amdgcn_s_barrier();
  f32x16 acc[2][2];
#pragma unroll
  for (int i = 0; i < 2; ++i)
#pragma unroll
    for (int j = 0; j < 2; ++j)
#pragma unroll
      for (int e = 0; e < 16; ++e) acc[i][j][e] = 0.f;
  const int rsw = (l32 >> 2) & 3;
  const int aoff = (wm * 64 + l32) * 64, boff = 16384 + (wn * 64 + l32) * 64;
  const int co0 = ((0 + hh) ^ rsw) << 4, co1 = ((2 + hh) ^ rsw) << 4;
  int cur = 0, nxt = 4 * STG;
  for (int kt = 0; kt < nk; kt += 2) {
    if (kt + 4 < nk) { DMA3(nxt, (kt + 4) * 32) DMA3(nxt + STG, (kt + 5) * 32) }
    const char* st = smem + cur;
    f16x8 a0[2], b0[2], a1[2], b1[2], a2[2], b2[2], a3[2], b3[2];
#pragma unroll
    for (int j = 0; j < 2; ++j) { b0[j] = *(const f16x8*)(st + boff + j * 2048 + co0); b1[j] = *(const f16x8*)(st + boff + j * 2048 + co1); }
#pragma unroll
    for (int i = 0; i < 2; ++i) { a0[i] = *(const f16x8*)(st + aoff + i * 2048 + co0); a1[i] = *(const f16x8*)(st + aoff + i * 2048 + co1); }
#pragma unroll
    for (int j = 0; j < 2; ++j) { b2[j] = *(const f16x8*)(st + STG + boff + j * 2048 + co0); b3[j] = *(const f16x8*)(st + STG + boff + j * 2048 + co1); }
#pragma unroll
    for (int i = 0; i < 2; ++i) { a2[i] = *(const f16x8*)(st + STG + aoff + i * 2048 + co0); a3[i] = *(const f16x8*)(st + STG + aoff + i * 2048 + co1); }
    __builtin_amdgcn_sched_barrier(0);
    if (kt + 4 < nk) asm volatile("s_waitcnt vmcnt(6) lgkmcnt(0)" ::: "memory");
    else asm volatile("s_waitcnt vmcnt(0) lgkmcnt(0)" ::: "memory");
    __builtin_amdgcn_s_barrier();
    __builtin_amdgcn_sched_barrier(0);
#pragma unroll
    for (int i = 0; i < 2; ++i)
#pragma unroll
      for (int j = 0; j < 2; ++j) acc[i][j] = MFMA(b0[j], a0[i], acc[i][j]);
#pragma unroll
    for (int i = 0; i < 2; ++i)
#pragma unroll
      for (int j = 0; j < 2; ++j) acc[i][j] = MFMA(b1[j], a1[i], acc[i][j]);
#pragma unroll
    for (int i = 0; i < 2; ++i)
#pragma unroll
      for (int j = 0; j < 2; ++j) acc[i][j] = MFMA(b2[j], a2[i], acc[i][j]);
#pragma unroll
    for (int i = 0; i < 2; ++i)
#pragma unroll
      for (int j = 0; j < 2; ++j) acc[i][j] = MFMA(b3[j], a3[i], acc[i][j]);
    __builtin_amdgcn_sched_barrier(0);
    __builtin_amdgcn_s_barrier();
    __builtin_amdgcn_sched_barrier(0);
    cur = cur == 4 * STG ? 0 : cur + 2 * STG;
    nxt = nxt == 4 * STG ? 0 : nxt + 2 * STG;
  }
  if (grp == 0) __builtin_amdgcn_s_barrier();
#undef DMA3
#pragma unroll
  for (int i = 0; i < 2; ++i)
#pragma unroll
    for (int j = 0; j < 2; ++j)
#pragma unroll
      for (int q = 0; q < 4; q += 2) {
        const int m = wm * 64 + i * 32 + l32, n = wn * 64 + j * 32 + 8 * q;
        const uint2 pa = epi(m, n + 4 * hh, acc[i][j][4 * q], acc[i][j][4 * q + 1], acc[i][j][4 * q + 2], acc[i][j][4 * q + 3]);
        const uint2 pb = epi(m, n + 8 + 4 * hh, acc[i][j][4 * q + 4], acc[i][j][4 * q + 5], acc[i][j][4 * q + 6], acc[i][j][4 * q + 7]);
        store_pair16(rowptr(m) + n, pa, pb, hh);
      }
}

template <class AF, class BF, class EF, class RF>
DI void gemm8w_m128(char* smem, int K, AF arow, BF brow, EF epi, RF rowptr) {
  constexpr int STG = 16384;
  const int tid = tidf_(), lane = tid & 63, wave = tid >> 6;
  const int grp = __builtin_amdgcn_readfirstlane(wave >> 2);
  const int wm = wave >> 1, wn = wave & 1, l32 = lane & 31, hh = lane >> 5;
  const int lr = lane >> 2, lc = ((lane & 3) ^ ((lane >> 4) & 3)) * 8;
  const f16* ap0 = arow(wave * 16 + lr) + lc;
  const f16* bp0 = brow(wave * 16 + lr) + lc;
  const int dA = wave * 1024 + lane * 16, dB = 8192 + wave * 1024 + lane * 16;
#define DMA3(stage_off, ko)                                                                                              \
  __builtin_amdgcn_global_load_lds((const void*)(ap0 + (ko)), (LAS void*)(smem + (stage_off) + dA), 16, 0, 0);          \
  __builtin_amdgcn_global_load_lds((const void*)(bp0 + (ko)), (LAS void*)(smem + (stage_off) + dB), 16, 0, 0);
  const int nk = K >> 5;
  DMA3(0, 0)
  DMA3(STG, 32)
  DMA3(2 * STG, 64)
  DMA3(3 * STG, 96)
  asm volatile("s_waitcnt vmcnt(4)" ::: "memory");
  __builtin_amdgcn_s_barrier();
  if (grp == 1) __builtin_amdgcn_s_barrier();
  f32x16 acc[1][2];
#pragma unroll
  for (int i = 0; i < 1; ++i)
#pragma unroll
    for (int j = 0; j < 2; ++j)
#pragma unroll
      for (int e = 0; e < 16; ++e) acc[i][j][e] = 0.f;
  const int rsw = (l32 >> 2) & 3;
  const int aoff = (wm * 32 + l32) * 64, boff = 8192 + (wn * 64 + l32) * 64;
  const int co0 = ((0 + hh) ^ rsw) << 4, co1 = ((2 + hh) ^ rsw) << 4;
  int cur = 0, nxt = 4 * STG;
  for (int kt = 0; kt < nk; kt += 2) {
    if (kt + 4 < nk) { DMA3(nxt, (kt + 4) * 32) DMA3(nxt + STG, (kt + 5) * 32) }
    const char* st = smem + cur;
    f16x8 a0[1], b0[2], a1[1], b1[2], a2[1], b2[2], a3[1], b3[2];
#pragma unroll
    for (int j = 0; j < 2; ++j) { b0[j] = *(const f16x8*)(st + boff + j * 2048 + co0); b1[j] = *(const f16x8*)(st + boff + j * 2048 + co1); }
#pragma unroll
    for (int i = 0; i < 1; ++i) { a0[i] = *(const f16x8*)(st + aoff + i * 2048 + co0); a1[i] = *(const f16x8*)(st + aoff + i * 2048 + co1); }
#pragma unroll
    for (int j = 0; j < 2; ++j) { b2[j] = *(const f16x8*)(st + STG + boff + j * 2048 + co0); b3[j] = *(const f16x8*)(st + STG + boff + j * 2048 + co1); }
#pragma unroll
    for (int i = 0; i < 1; ++i) { a2[i] = *(const f16x8*)(st + STG + aoff + i * 2048 + co0); a3[i] = *(const f16x8*)(st + STG + aoff + i * 2048 + co1); }
    __builtin_amdgcn_sched_barrier(0);
    if (kt + 4 < nk) asm volatile("s_waitcnt vmcnt(4) lgkmcnt(0)" ::: "memory");
    else asm volatile("s_waitcnt vmcnt(0) lgkmcnt(0)" ::: "memory");
    __builtin_amdgcn_s_barrier();
    __builtin_amdgcn_sched_barrier(0);
#pragma unroll
    for (int i = 0; i < 1; ++i)
#pragma unroll
      for (int j = 0; j < 2; ++j) acc[i][j] = MFMA(b0[j], a0[i], acc[i][j]);
#pragma unroll
    for (int i = 0; i < 1; ++i)
#pragma unroll
      for (int j = 0; j < 2; ++j) acc[i][j] = MFMA(b1[j], a1[i], acc[i][j]);
#pragma unroll
    for (int i = 0; i < 1; ++i)
#pragma unroll
      for (int j = 0; j < 2; ++j) acc[i][j] = MFMA(b2[j], a2[i], acc[i][j]);
#pragma unroll
    for (int i = 0; i < 1; ++i)
#pragma unroll
      for (int j = 0; j < 2; ++j) acc[i][j] = MFMA(b3[j], a3[i], acc[i][j]);
    __builtin_amdgcn_sched_barrier(0);
    __builtin_amdgcn_s_barrier();
    __builtin_amdgcn_sched_barrier(0);
    cur = cur == 4 * STG ? 0 : cur + 2 * STG;
    nxt = nxt == 4 * STG ? 0 : nxt + 2 * STG;
  }
  if (grp == 0) __builtin_amdgcn_s_barrier();
#undef DMA3
#pragma unroll
  for (int i = 0; i < 1; ++i)
#pragma unroll
    for (int j = 0; j < 2; ++j)
#pragma unroll
      for (int q = 0; q < 4; q += 2) {
        const int m = wm * 32 + i * 32 + l32, n = wn * 64 + j * 32 + 8 * q;
        const uint2 pa = epi(m, n + 4 * hh, acc[i][j][4 * q], acc[i][j][4 * q + 1], acc[i][j][4 * q + 2], acc[i][j][4 * q + 3]);
        const uint2 pb = epi(m, n + 8 + 4 * hh, acc[i][j][4 * q + 4], acc[i][j][4 * q + 5], acc[i][j][4 * q + 6], acc[i][j][4 * q + 7]);
        store_pair16(rowptr(m) + n, pa, pb, hh);
      }
}

DI uint2 pack4h(float a, float b, float c, float d) {
  f16x4 v;
  v[0] = (f16)a; v[1] = (f16)b; v[2] = (f16)c; v[3] = (f16)d;
  return __builtin_bit_cast(uint2, v);
}
DI void store_pair16(f16* dst, uint2 a, uint2 b, int hh) {
  const auto r0 = __builtin_amdgcn_permlane32_swap(a.x, b.x, false, false);
  const auto r1 = __builtin_amdgcn_permlane32_swap(a.y, b.y, false, false);
  uint4 o; o.x = r0[0]; o.y = r1[0]; o.z = r0[1]; o.w = r1[1];
  *(uint4*)(dst + 8 * hh) = o;
}
DI void store4h(f16* dst, float a, float b, float c, float d) {
  f16x4 v;
  v[0] = (f16)a; v[1] = (f16)b; v[2] = (f16)c; v[3] = (f16)d;
  *(f16x4*)dst = v;
}

DI void tconv_tile(char* smem, const float* src, int lds, f16* dst, int ldd, int k0, int n0) {
  float* t = (float*)smem;
  const int tid = tid_();
#pragma unroll
  for (int j = 0; j < 4; ++j) {
    const int r = (tid >> 4) + 16 * j, c4 = (tid & 15) * 4;
    const float4 v = *(const float4*)(src + (size_t)(k0 + r) * lds + n0 + c4);
    t[r * 65 + c4] = v.x; t[r * 65 + c4 + 1] = v.y; t[r * 65 + c4 + 2] = v.z; t[r * 65 + c4 + 3] = v.w;
  }
  __syncthreads();
  const int n = tid >> 2, kc = (tid & 3) * 16;
  f16x8 o0, o1;
#pragma unroll
  for (int i = 0; i < 8; ++i) { o0[i] = (f16)t[(kc + i) * 65 + n]; o1[i] = (f16)t[(kc + 8 + i) * 65 + n]; }
  f16* d = dst + (size_t)(n0 + n) * ldd + k0 + kc;
  *(f16x8*)d = o0;
  *(f16x8*)(d + 8) = o1;
  __syncthreads();
}

DI void ada_item(KP P, char* smem, int item) {
  const int tid = tid_(), lane = tid & 63, wave = tid >> 6;
  const int layer = item / 96, rem = item % 96, cb = rem >> 2, kc = rem & 3;
  float* sc = (float*)smem;
  float* red = (float*)smem + 1280;
  for (int i = tid; i < 1280; i += 256) {
    const int j = i >> 8, k = kc * 256 + (i & 255);
    const float v = j == 0 ? P->c_ctx[k] : P->c[(j - 1) * 1024 + k];
    sc[i] = v / (1.f + __expf(-v));
  }
  __syncthreads();
  float a[5][4];
#pragma unroll
  for (int j = 0; j < 5; ++j)
#pragma unroll
    for (int e = 0; e < 4; ++e) a[j][e] = 0.f;
  const float* w = P->ada_w + ((size_t)layer * 1024 + kc * 256 + wave * 64) * 6144 + cb * 256 + lane * 4;
#pragma unroll 8
  for (int i = 0; i < 64; ++i) {
    const float4 v = *(const float4*)(w + (size_t)i * 6144);
#pragma unroll
    for (int j = 0; j < 5; ++j) {
      const float s = sc[j * 256 + wave * 64 + i];
      a[j][0] += s * v.x; a[j][1] += s * v.y; a[j][2] += s * v.z; a[j][3] += s * v.w;
    }
  }
#pragma unroll
  for (int j = 0; j < 5; ++j)
#pragma unroll
    for (int e = 0; e < 4; ++e) red[(wave * 5 + j) * 256 + lane * 4 + e] = a[j][e];
  __syncthreads();
  float* adap = (float*)(P->ws + WS_ADAP);
#pragma unroll
  for (int j = 0; j < 5; ++j) {
    const float s = red[(0 * 5 + j) * 256 + tid] + red[(1 * 5 + j) * 256 + tid] + red[(2 * 5 + j) * 256 + tid] +
                    red[(3 * 5 + j) * 256 + tid];
    adap[((layer * 4 + kc) * 5 + j) * 6144 + cb * 256 + tid] = s;
  }
  __syncthreads();
}

DI void const_item(KP P, int item) {
  f16* fc = (f16*)(P->ws + WS_FC);
  f16* d256 = (f16*)(P->ws + WS_D256);
  f16* f64 = (f16*)(P->ws + WS_F64);
  f16* ds = (f16*)(P->ws + WS_DS);
#pragma unroll 1
  for (int j = 0; j < 8; ++j) {
    int e = item * 2048 + j * 256 + tid_();
    float sn, cs;
    if (e < 32768) {
      const int m = e >> 7, c = e & 127, l = m >> 1, ri = m & 1;
      sincospif((float)((l * c) & 127) * (1.f / 64.f), &sn, &cs);
      fc[e] = (f16)((ri ? -sn : cs) * 0.08838834764831845f);
    } else if (e < 32768 + 131072) {
      e -= 32768;
      const int k = e >> 9, col = e & 511, ri = col >> 8, s = col & 255;
      sincospif((float)((k * s) & 255) * (1.f / 128.f), &sn, &cs);
      d256[e] = (f16)((ri ? sn : cs) * 0.0625f);
    } else if (e < 32768 + 131072 + 16384) {
      e -= 32768 + 131072;
      const int n = e >> 7, col = e & 127, rip = n >> 6, k2 = n & 63, ri = col >> 6, s2 = col & 63;
      sincospif((float)((k2 * s2) & 63) * (1.f / 32.f), &sn, &cs);
      f64[e] = (f16)((rip == ri ? cs : (rip == 0 ? sn : -sn)) * 0.125f);
    } else {
      e -= 32768 + 131072 + 16384;
      const int k = e >> 7, col = e & 127, ri = col >> 6, s1 = col & 63;
      sincospif((float)((k * s1) & 4095) * (1.f / 2048.f), &sn, &cs);
      ds[e] = (f16)((ri ? sn : cs) * 0.125f);
    }
  }
}

DI void phase_prep(KP P, char* smem) {
  constexpr int NADA = 192, NTC = 5792, NCONST = 344;
  smem += half_() * kHalfLds;
  for (int it = blockIdx.x * 2 + half_(); it < NADA + NTC + NCONST; it += gridDim.x * 2) {
    if (it < NADA) {
      ada_item(P, smem, it);
    } else if (it < NADA + NTC) {
      int i = it - NADA;
      const float* src; f16* dst; int K, N;
      if (i < 384) { src = P->e_w_in; dst = (f16*)(P->ws + WS_WIN); K = 1024; N = 1536; }
      else if (i < 640) { i -= 384; src = P->e_w_out; dst = (f16*)(P->ws + WS_WOUT0); K = 1024; N = 1024; }
      else if (i < 2688) { i -= 640; const int l = i >> 10; i &= 1023; src = P->w1 + (size_t)l * 1024 * 4096; dst = (f16*)(P->ws + WS_W1) + (size_t)l * 4096 * 1024; K = 1024; N = 4096; }
      else if (i < 4736) { i -= 2688; const int l = i >> 10; i &= 1023; src = P->w2 + (size_t)l * 4096 * 1024; dst = (f16*)(P->ws + WS_W2) + (size_t)l * 1024 * 4096; K = 4096; N = 1024; }
      else if (i < 5504) { i -= 4736; src = P->o_w_qkv; dst = (f16*)(P->ws + WS_WQKV); K = 1024; N = 3072; }
      else if (i < 5760) { i -= 5504; src = P->o_w_out; dst = (f16*)(P->ws + WS_WO1); K = 1024; N = 1024; }
      else {
        i -= 5760;
        const int hb = i & 7, ri = (i >> 3) & 1, d = i >> 4;
        src = (ri ? P->e_w_i : P->e_w_r) + (size_t)(d * 8 + hb) * 4096;
        dst = (f16*)(P->ws + WS_GW) + (size_t)i * 4096;
        K = 64; N = 64; i = 0;
      }
      const int ntn = N >> 6;
      tconv_tile(smem, src, N, dst, K, (i / ntn) * 64, (i % ntn) * 64);
    } else {
      const_item(P, it - NADA - NTC);
    }
  }
}

#define DPP_ADD(v, ctrl) ((v) + __builtin_bit_cast(float, __builtin_amdgcn_update_dpp(0, __builtin_bit_cast(int, (v)), (ctrl), 0xF, 0xF, true)))
DI float wave_allsum_dpp(float v) {
  v = DPP_ADD(v, 0xB1);
  v = DPP_ADD(v, 0x4E);
  v = DPP_ADD(v, 0x141);
  v = DPP_ADD(v, 0x140);
  const unsigned u = __builtin_bit_cast(unsigned, v);
  const auto r16 = __builtin_amdgcn_permlane16_swap(u, u, false, false);
  v = __builtin_bit_cast(float, (unsigned)r16[0]) + __builtin_bit_cast(float, (unsigned)r16[1]);
  const unsigned w = __builtin_bit_cast(unsigned, v);
  const auto r32 = __builtin_amdgcn_permlane32_swap(w, w, false, false);
  return __builtin_bit_cast(float, (unsigned)r32[0]) + __builtin_bit_cast(float, (unsigned)r32[1]);
}
constexpr int LNB = 5;
DI void wave_sum_n(float (&s)[LNB]) {
#pragma unroll
  for (int o = 32; o; o >>= 1)
#pragma unroll
    for (int r = 0; r < LNB; ++r) s[r] += __shfl_xor(s[r], o);
}
DI void ln_stats(float (&v)[LNB][16], float (&rstd)[LNB]) {
  float s[LNB], s2[LNB];
#pragma unroll
  for (int r = 0; r < LNB; ++r) {
    s[r] = 0.f; s2[r] = 0.f;
#pragma unroll
    for (int k = 0; k < 16; ++k) { s[r] += v[r][k]; s2[r] = fmaf(v[r][k], v[r][k], s2[r]); }
  }
#pragma unroll
  for (int r = 0; r < LNB; ++r) { s[r] = wave_allsum_dpp(s[r]); s2[r] = wave_allsum_dpp(s2[r]); }
#pragma unroll
  for (int r = 0; r < LNB; ++r) {
    const float mean = s[r] * (1.f / 1024.f);
    const float var = fmaxf(s2[r] * (1.f / 1024.f) - mean * mean, 0.f);
    rstd[r] = rsqrtf(var + 1e-5f);
#pragma unroll
    for (int k = 0; k < 16; ++k) v[r][k] -= mean;
  }
}

template <bool SRC_INPUT, bool HAS_LN, bool HAS_MOD, bool DST_OUT>
DI void phase_ln(KP P, const float* g_, const float* b_, int layer, int shift_idx, int scale_idx) {
  const int tid = tidf_(), lane = tid & 63, wave = tid >> 6;
  if (SRC_INPUT) {
    const int e = blockIdx.x * 512 + tid;
    if (e < 2 * 5 * 6144) {
      const int layer_ = e / 30720, rem = e % 30720;
      ((float*)(P->ws + WS_ADAF))[e] = ada_val(P, layer_, rem / 6144, rem % 6144);
    }
  }
  f16* xr = (f16*)(P->ws + WS_XR);
  f16* hbuf = (f16*)(P->ws + WS_H);
  const int nw = gridDim.x * 8, rpw = (T + nw - 1) / nw;
  const int r_begin = (blockIdx.x * 8 + wave) * rpw, r_end = min(T, r_begin + rpw);
  float g[16], bb[16], sc[16], sh[16];
#pragma unroll
  for (int k = 0; k < 16; ++k) {
    const int col = (k >> 2) * 256 + lane * 4 + (k & 3);
    if (HAS_LN) { g[k] = g_[col]; bb[k] = b_[col]; } else { g[k] = 1.f; bb[k] = 0.f; }
    sc[k] = 1.f; sh[k] = 0.f;
  }
  int cur = -1;
#pragma unroll 1
  for (int t = r_begin; t < r_end; t += LNB) {
    float v[LNB][16], rstd[LNB];
#pragma unroll
    for (int r = 0; r < LNB; ++r) {
      const int tt = min(t + r, r_end - 1);
      if (SRC_INPUT) {
        const float* src = tt < TP ? P->x_prompt + (size_t)tt * 1024 : P->x_sample + (size_t)(tt - TP) * 1024;
#pragma unroll
        for (int j = 0; j < 4; ++j) {
          const float4 q = *(const float4*)(src + j * 256 + lane * 4);
          v[r][j * 4] = q.x; v[r][j * 4 + 1] = q.y; v[r][j * 4 + 2] = q.z; v[r][j * 4 + 3] = q.w;
        }
      } else {
#pragma unroll
        for (int j = 0; j < 4; ++j) {
          const f16x4 q = *(const f16x4*)(xr + (size_t)tt * 1024 + j * 256 + lane * 4);
          v[r][j * 4] = (float)q[0]; v[r][j * 4 + 1] = (float)q[1]; v[r][j * 4 + 2] = (float)q[2]; v[r][j * 4 + 3] = (float)q[3];
        }
      }
    }
    ln_stats(v, rstd);
    if (HAS_LN) {
#pragma unroll
      for (int r = 0; r < LNB; ++r) {
#pragma unroll
        for (int k = 0; k < 16; ++k) v[r][k] = v[r][k] * rstd[r] * g[k] + bb[k];
        if (t + r < r_end) {
          if (DST_OUT) {
            float* dst = P->out + (size_t)(t + r) * 1024;
#pragma unroll
            for (int j = 0; j < 4; ++j) {
              float4 q; q.x = v[r][j * 4]; q.y = v[r][j * 4 + 1]; q.z = v[r][j * 4 + 2]; q.w = v[r][j * 4 + 3];
              *(float4*)(dst + j * 256 + lane * 4) = q;
            }
          } else {
#pragma unroll
            for (int j = 0; j < 4; ++j)
              store4h(xr + (size_t)(t + r) * 1024 + j * 256 + lane * 4, v[r][j * 4], v[r][j * 4 + 1], v[r][j * 4 + 2], v[r][j * 4 + 3]);
          }
        }
      }
      if (HAS_MOD) ln_stats(v, rstd);
    }
    if (HAS_MOD) {
#pragma unroll
      for (int r = 0; r < LNB; ++r) {
        if (t + r < r_end) {
          const int cond = cond_of(t + r);
          if (cond != cur) {
            cur = cond;
#pragma unroll
            for (int k = 0; k < 16; ++k) {
              const int col = (k >> 2) * 256 + lane * 4 + (k & 3);
              sh[k] = SRC_INPUT ? ada_val(P, layer, cond, shift_idx * 1024 + col) : adaf(P, layer, cond, shift_idx * 1024 + col);
              sc[k] = 1.f + (SRC_INPUT ? ada_val(P, layer, cond, scale_idx * 1024 + col) : adaf(P, layer, cond, scale_idx * 1024 + col));
            }
          }
          f16* hd = hbuf + (size_t)(t + r) * 1024;
#pragma unroll
          for (int j = 0; j < 4; ++j)
            store4h(hd + j * 256 + lane * 4, v[r][j * 4] * rstd[r] * sc[j * 4] + sh[j * 4], v[r][j * 4 + 1] * rstd[r] * sc[j * 4 + 1] + sh[j * 4 + 1],
                    v[r][j * 4 + 2] * rstd[r] * sc[j * 4 + 2] + sh[j * 4 + 2], v[r][j * 4 + 3] * rstd[r] * sc[j * 4 + 3] + sh[j * 4 + 3]);
        }
      }
    }
  }
}

DI void scan_item(KP P, char* smem, int item, int mode) {
  const int tid = tid_(), lane = tid & 63, wave = tid >> 6, l32 = lane & 31, hh = lane >> 5;
  const int c = item >> 3, hb = item & 7;
  const int t0 = c * 64;
  const bool ctx = c < 64;
  const int bstart = ctx ? (c >> 2) * 256 : TP + ((c - 64) >> 6) * 4096;
  const int bend = bstart + (ctx ? 256 : 4096);
  const f16* u = (const f16*)(P->ws + WS_B1);
  float2* sum = (float2*)(P->ws + WS_SUM);
  float hcarry = 0.f;
  if (mode == 1) {
    const int cfirst = ctx ? (c & ~3) : 64 + ((c - 64) & ~63);
    const int clast = ctx ? (c | 3) : 64 + ((c - 64) | 63);
    const int nf = c - cfirst, nb = clast - c;
    float2* car = (float2*)smem;
    for (int idx = tid; idx < (nf + nb) * 64; idx += 256) {
      const int q = idx >> 6, nn = idx & 63;
      car[idx] = q < nf ? sum[(size_t)((cfirst + q) * 2) * 512 + hb * 64 + nn]
                        : sum[(size_t)((clast - (q - nf)) * 2 + 1) * 512 + hb * 64 + nn];
    }
    __syncthreads();
    if (tid < 128) {
      const int dd = tid >> 6, nn = tid & 63;
      const int lb = ctx ? 0 : ((c - 64) >> 6);
      float h = ctx ? 0.f : P->state_lru[(lb * 2 + dd) * 512 + hb * 64 + nn];
      const int q0 = dd ? nf : 0, q1 = dd ? nf + nb : nf;
#pragma unroll 4
      for (int q = q0; q < q1; ++q) { const float2 sv = car[q * 64 + nn]; h = sv.x * h + sv.y; }
      hcarry = h;
    }
    __syncthreads();
  }
  {
    const int tok = tid >> 2, cb = (tid & 3) * 16, t = t0 + tok, ch0 = hb * 64 + cb;
    float acc[16];
#pragma unroll
    for (int i = 0; i < 4; ++i) {
      const float4 q = *(const float4*)(P->e_conv_b + ch0 + 4 * i);
      acc[4 * i] = q.x; acc[4 * i + 1] = q.y; acc[4 * i + 2] = q.z; acc[4 * i + 3] = q.w;
    }
#pragma unroll
    for (int k = 0; k < 4; ++k) {
      const int tt = t + k - 2;
      if (tt >= bstart && tt < bend) {
        const f16x8 x0 = *(const f16x8*)(u + (size_t)tt * 1536 + ch0);
        const f16x8 x1 = *(const f16x8*)(u + (size_t)tt * 1536 + ch0 + 8);
        float xv[16];
#pragma unroll
        for (int i = 0; i < 8; ++i) { xv[i] = (float)x0[i]; xv[8 + i] = (float)x1[i]; }
#pragma unroll
        for (int i = 0; i < 4; ++i) {
          const float4 wq = *(const float4*)(P->e_conv_w + k * 512 + ch0 + 4 * i);
          acc[4 * i] += wq.x * xv[4 * i]; acc[4 * i + 1] += wq.y * xv[4 * i + 1];
          acc[4 * i + 2] += wq.z * xv[4 * i + 2]; acc[4 * i + 3] += wq.w * xv[4 * i + 3];
        }
      }
    }
    f16x8 o0, o1;
#pragma unroll
    for (int i = 0; i < 8; ++i) { o0[i] = (f16)acc[i]; o1[i] = (f16)acc[8 + i]; }
    *(f16x8*)(smem + tok * 144 + cb * 2) = o0;
    *(f16x8*)(smem + tok * 144 + cb * 2 + 16) = o1;
  }
  {
    const f16* gw = (const f16*)(P->ws + WS_GW);
#pragma unroll
    for (int i = 0; i < 8; ++i) {
      const int id = tid + 256 * i, mat = id >> 9, rem = id & 511, n = rem >> 3, ch = rem & 7;
      const uint4 v = *(const uint4*)(gw + (size_t)(mat * 8 + hb) * 4096 + n * 64 + ch * 8);
      *(uint4*)(smem + 9216 + mat * 9216 + n * 144 + ch * 16) = v;
    }
  }
  __syncthreads();
  const int d = wave >> 1, nh = wave & 1;
  const int n = nh * 32 + l32, ch = hb * 64 + n;
  f32x16 accr0, accr1, acci0, acci1;
#pragma unroll
  for (int i = 0; i < 16; ++i) { accr0[i] = 0.f; accr1[i] = 0.f; acci0[i] = 0.f; acci1[i] = 0.f; }
#pragma unroll
  for (int ks = 0; ks < 4; ++ks) {
    const int ko = (ks * 16 + hh * 8) * 2;
    const f16x8 a0 = *(const f16x8*)(smem + l32 * 144 + ko);
    const f16x8 a1 = *(const f16x8*)(smem + (32 + l32) * 144 + ko);
    const f16x8 br = *(const f16x8*)(smem + 9216 + (d * 2) * 9216 + n * 144 + ko);
    const f16x8 bi = *(const f16x8*)(smem + 9216 + (d * 2 + 1) * 9216 + n * 144 + ko);
    accr0 = MFMA(a0, br, accr0);
    accr1 = MFMA(a1, br, accr1);
    acci0 = MFMA(a0, bi, acci0);
    acci1 = MFMA(a1, bi, acci1);
  }
  float xcv0[16], xcv1[16];
#pragma unroll
  for (int r = 0; r < 16; ++r) {
    xcv0[r] = (float)*(const f16*)(smem + crow(r, hh) * 144 + n * 2);
    xcv1[r] = (float)*(const f16*)(smem + (32 + crow(r, hh)) * 144 + n * 2);
  }
  __syncthreads();
  {
    const float brv = P->e_b_r[d * 512 + ch], biv = P->e_b_i[d * 512 + ch];
    const float sp = log1pf(__expf(-P->e_lam[d * 512 + ch]));
    float* as = (float*)smem + d * 4096;
    float* bs = (float*)smem + 8192 + d * 4096;
#pragma unroll
    for (int r = 0; r < 16; ++r) {
      {
        const int tok = crow(r, hh);
        const float rr = sigmoidf_(accr0[r] + brv), ii = sigmoidf_(acci0[r] + biv);
        const float la = -8.f * rr * sp;
        const float av = __expf(la);
        as[tok * 64 + n] = av;
        bs[tok * 64 + n] = __builtin_amdgcn_sqrtf(fmaxf(fmaf(-av, av, 1.f), 0.f)) * ii * xcv0[r];
      }
      {
        const int tok = 32 + crow(r, hh);
        const float rr = sigmoidf_(accr1[r] + brv), ii = sigmoidf_(acci1[r] + biv);
        const float la = -8.f * rr * sp;
        const float av = __expf(la);
        as[tok * 64 + n] = av;
        bs[tok * 64 + n] = __builtin_amdgcn_sqrtf(fmaxf(fmaf(-av, av, 1.f), 0.f)) * ii * xcv1[r];
      }
    }
  }
  __syncthreads();
  if (tid < 128) {
    const int dd = tid >> 6, nn = tid & 63, cc_ = hb * 64 + nn;
    const float* as = (const float*)smem + dd * 4096 + nn;
    float* bs = (float*)smem + 8192 + dd * 4096 + nn;
    float h = hcarry, p = 1.f;
#pragma unroll 1
    for (int blk = 0; blk < 8; ++blk) {
      const int tb = dd ? 56 - blk * 8 : blk * 8;
      float av[8], bv[8];
#pragma unroll
      for (int i = 0; i < 8; ++i) { av[i] = as[(tb + i) * 64]; bv[i] = bs[(tb + i) * 64]; }
      if (dd == 0) {
#pragma unroll
        for (int i = 0; i < 8; ++i) { h = av[i] * h + bv[i]; p *= av[i]; bv[i] = h; }
      } else {
#pragma unroll
        for (int i = 7; i >= 0; --i) { h = av[i] * h + bv[i]; p *= av[i]; bv[i] = h; }
      }
      if (mode == 1) {
#pragma unroll
        for (int i = 0; i < 8; ++i) bs[(tb + i) * 64] = bv[i];
      }
    }
    if (mode == 0) {
      sum[(size_t)(c * 2 + dd) * 512 + cc_] = make_float2(p, h);
    } else if (ctx) {
      if (dd == 0 && (c & 3) == 3) P->out[OUT_LRU + ((c >> 2) * 2 + 0) * 512 + cc_] = h;
      if (dd == 1 && (c & 3) == 0) P->out[OUT_LRU + ((c >> 2) * 2 + 1) * 512 + cc_] = h;
    }
  }
  __syncthreads();
  if (mode == 1) {
    const int tok = tid >> 2, cb = (tid & 3) * 16, t = t0 + tok;
    const float* hf = (const float*)smem + 8192 + tok * 64 + cb;
    const float* hbw = hf + 4096;
    const f16x8 g0 = *(const f16x8*)(u + (size_t)t * 1536 + 512 + hb * 64 + cb);
    const f16x8 g1 = *(const f16x8*)(u + (size_t)t * 1536 + 512 + hb * 64 + cb + 8);
    f16x8 o0, o1;
#pragma unroll
    for (int i = 0; i < 8; ++i) {
      float x = (float)g0[i];
      float gl = x * sigmoidf_(1.5957691216057308f * (x + 0.044715f * x * x * x));
      o0[i] = (f16)((hf[i] + hbw[i]) * gl);
      x = (float)g1[i];
      gl = x * sigmoidf_(1.5957691216057308f * (x + 0.044715f * x * x * x));
      o1[i] = (f16)((hf[8 + i] + hbw[8 + i]) * gl);
    }
    f16* yc = (f16*)(P->ws + WS_H) + (size_t)t * 1024 + hb * 64 + cb;
    *(f16x8*)yc = o0;
    *(f16x8*)(yc + 8) = o1;
    __syncthreads();
  }
}

template <int MODE>
DI void attn_tile(const char* kb_, const char* vb_, const char* bt, const int (&bi0)[16], const int (&bi1)[16], const f16x8 q0,
                  const f16x8 q1, const f16x8 q2, const f16x8 q3, float& m, float& lsum, f32x16& o0, f32x16& o1, int l32, int hh, int rsw) {
#define LIVE0(r) (MODE != 2 || (r) >= 12)
#define LIVE1(r) (MODE != 1 || (r) < 4)
  f32x16 s0, s1;
#pragma unroll
  for (int i = 0; i < 16; ++i) { s0[i] = 0.f; s1[i] = 0.f; }
  {
    int co = ((0 + hh) ^ rsw) << 4;
    s0 = MFMA(*(const f16x8*)(kb_ + l32 * 128 + co), q0, s0);
    s1 = MFMA(*(const f16x8*)(kb_ + (32 + l32) * 128 + co), q0, s1);
    co = ((2 + hh) ^ rsw) << 4;
    s0 = MFMA(*(const f16x8*)(kb_ + l32 * 128 + co), q1, s0);
    s1 = MFMA(*(const f16x8*)(kb_ + (32 + l32) * 128 + co), q1, s1);
    co = ((4 + hh) ^ rsw) << 4;
    s0 = MFMA(*(const f16x8*)(kb_ + l32 * 128 + co), q2, s0);
    s1 = MFMA(*(const f16x8*)(kb_ + (32 + l32) * 128 + co), q2, s1);
    co = ((6 + hh) ^ rsw) << 4;
    s0 = MFMA(*(const f16x8*)(kb_ + l32 * 128 + co), q3, s0);
    s1 = MFMA(*(const f16x8*)(kb_ + (32 + l32) * 128 + co), q3, s1);
  }
  if (MODE != 0) {
#pragma unroll
    for (int r = 0; r < 16; ++r) {
      if (LIVE0(r)) s0[r] += *(const float*)(bt + bi0[r]);
      if (LIVE1(r)) s1[r] += *(const float*)(bt + bi1[r]);
    }
  }
  float mx = -INFINITY;
#pragma unroll
  for (int r = 0; r < 16; ++r) {
    if (LIVE0(r)) mx = fmaxf(mx, s0[r]);
    if (LIVE1(r)) mx = fmaxf(mx, s1[r]);
  }
  mx = fmaxf(mx, __shfl_xor(mx, 32));
  const float mn = fmaxf(m, mx);
  const float alpha = __builtin_amdgcn_exp2f(m - mn);
  m = mn;
  float ps0 = 0.f, ps1 = 0.f;
#pragma unroll
  for (int r = 0; r < 16; ++r) {
    if (LIVE0(r)) { s0[r] = __builtin_amdgcn_exp2f(s0[r] - mn); ps0 += s0[r]; } else s0[r] = 0.f;
    if (LIVE1(r)) { s1[r] = __builtin_amdgcn_exp2f(s1[r] - mn); ps1 += s1[r]; } else s1[r] = 0.f;
  }
  lsum = lsum * alpha + (ps0 + ps1);
  if (__any(alpha != 1.f)) {
#pragma unroll
    for (int r = 0; r < 16; ++r) { o0[r] *= alpha; o1[r] *= alpha; }
  }
#pragma unroll
  for (int kb = 0; kb < 2; ++kb)
#pragma unroll
    for (int st = 0; st < 2; ++st) {
      if ((MODE == 1 && kb == 1 && st == 1) || (MODE == 2 && kb == 0 && st == 0)) continue;
      typedef __attribute__((ext_vector_type(2))) __fp16 h2_t;
      typedef __attribute__((ext_vector_type(4))) unsigned u4_t;
      u4_t pu;
#pragma unroll
      for (int e = 0; e < 4; ++e) {
        const h2_t hv = kb == 0 ? __builtin_amdgcn_cvt_pkrtz(s0[8 * st + 2 * e], s0[8 * st + 2 * e + 1])
                                : __builtin_amdgcn_cvt_pkrtz(s1[8 * st + 2 * e], s1[8 * st + 2 * e + 1]);
        pu[e] = __builtin_bit_cast(unsigned, hv);
      }
      const f16x8 pf = __builtin_bit_cast(f16x8, pu);
      const int c0 = ((4 * kb + 2 * st) ^ rsw) << 4, c1 = ((4 * kb + 2 * st + 1) ^ rsw) << 4;
      {
        const f16x4 lo = *(const f16x4*)(vb_ + l32 * 128 + c0 + 8 * hh);
        const f16x4 hi = *(const f16x4*)(vb_ + l32 * 128 + c1 + 8 * hh);
        const f16x8 va = __builtin_shufflevector(lo, hi, 0, 1, 2, 3, 4, 5, 6, 7);
        o0 = MFMA(va, pf, o0);
      }
      {
        const f16x4 lo = *(const f16x4*)(vb_ + (32 + l32) * 128 + c0 + 8 * hh);
        const f16x4 hi = *(const f16x4*)(vb_ + (32 + l32) * 128 + c1 + 8 * hh);
        const f16x8 va = __builtin_shufflevector(lo, hi, 0, 1, 2, 3, 4, 5, 6, 7);
        o1 = MFMA(va, pf, o1);
      }
    }
#undef LIVE0
#undef LIVE1
}

DI void attn_item(KP P, char* smem, int item) {
  constexpr int NS = 6, PD = 4;
  const int tid = tidf_(), lane = tid & 63, wave = tid >> 6, l32 = lane & 31, hh = lane >> 5;
  const int sub = wave >> 1, sw = wave & 1;
  float* rpbs = (float*)(smem + NS * 16384);
  const bool latent = item < 1024;
  const int sid = (latent ? item : item - 1024) * 4 + sub;
  const f16* qbuf = (const f16*)(P->ws + WS_B1);
  const f16* kbuf = qbuf + (size_t)T * 1024;
  const char* b2 = (const char*)P->out;
  int b, h, row = 0, rs = 0, qtok0, ntiles, nloc = 0, a0 = 0;
  if (latent) {
    b = sid >> 10; h = (sid >> 6) & 15; row = sid & 63; rs = min(max(row - 4, 0), 56); qtok0 = TP + b * 4096 + row * 64;
    const int r0 = row & ~3;
    a0 = min(max(r0 - 4, 0), 56);
    const int a1 = min(max(r0 - 1, 0), 56) + 7;
    nloc = a1 - a0 + 1; ntiles = nloc + 8;
  } else { b = sid >> 6; h = (sid >> 2) & 15; qtok0 = b * 256 + (sid & 3) * 64; ntiles = 4; }
  const int drow = wave * 8 + (lane >> 3), dch = ((lane & 7) ^ ((drow >> 1) & 7)) * 8;
  const int dlds = wave * 1024 + lane * 16;
  auto dma = [&](int j) {
    const f16 *kp, *vp; size_t kst, vst;
    if (latent) {
      if (j < nloc) {
        kp = kbuf + (size_t)(TP + b * 4096 + (a0 + j) * 64) * 1024 + h * 64; kst = 1024;
        vp = (const f16*)(b2 + B2_VTL) + (size_t)((b * 16 + h) * 64) * 4096 + (a0 + j) * 64; vst = 4096;
      } else {
        kp = (const f16*)(b2 + B2_CK) + (size_t)((b * 16 + h) * 512 + (j - nloc) * 64) * 64; kst = 64;
        vp = (const f16*)(b2 + B2_CVT) + (size_t)((b * 16 + h) * 64) * 512 + (j - nloc) * 64; vst = 512;
      }
    } else {
      kp = kbuf + (size_t)(b * 256 + j * 64) * 1024 + h * 64; kst = 1024;
      vp = (const f16*)(b2 + B2_VTC) + (size_t)((b * 16 + h) * 64) * 256 + j * 64; vst = 256;
    }
    char* st = smem + (j % NS) * 16384;
    __builtin_amdgcn_global_load_lds((const void*)(kp + (size_t)drow * kst + dch), (LAS void*)(st + dlds), 16, 0, 0);
    __builtin_amdgcn_global_load_lds((const void*)(vp + (size_t)drow * vst + dch), (LAS void*)(st + 8192 + dlds), 16, 0, 0);
  };
#pragma unroll
  for (int j = 0; j < PD; ++j) if (j < ntiles) dma(j);
  if (latent) for (int i = tid; i < 480; i += 512) { const int rr = i >> 5, cc = i & 31; rpbs[i] = cc < 31 ? P->o_rpb[h * 465 + rr * 31 + cc] * LOG2E : -INFINITY; }
  const int qc = sw * 32 + l32;
  const f16* qp = qbuf + (size_t)(qtok0 + qc) * 1024 + h * 64 + hh * 8;
  const f16x8 q0 = *(const f16x8*)qp, q1 = *(const f16x8*)(qp + 16), q2 = *(const f16x8*)(qp + 32), q3 = *(const f16x8*)(qp + 48);
  __syncthreads();
  float m = -INFINITY, lsum = 0.f;
  f32x16 o0, o1;
#pragma unroll
  for (int i = 0; i < 16; ++i) { o0[i] = 0.f; o1[i] = 0.f; }
  const int rsw = (l32 >> 1) & 7;
  const int cs = min(max(qc - 8, 0), 48);
  int bi0[16], bi1[16];
#pragma unroll
  for (int r = 0; r < 16; ++r) {
    const int k0 = crow(r, hh), k1 = 32 + k0;
    bi0[r] = ((k0 >= cs && k0 < cs + 16) ? (k0 - qc + 15) : 31) * 4;
    bi1[r] = ((k1 >= cs && k1 < cs + 16) ? (k1 - qc + 15) : 31) * 4;
  }
#pragma unroll 1
  for (int j = 0; j < ntiles; ++j) {
    if (j + PD < ntiles) dma(j + PD);
    {
      const int ahead = min(PD, ntiles - 1 - j);
      if (ahead >= 4) asm volatile("s_waitcnt vmcnt(8)" ::: "memory");
      else if (ahead == 3) asm volatile("s_waitcnt vmcnt(6)" ::: "memory");
      else if (ahead == 2) asm volatile("s_waitcnt vmcnt(4)" ::: "memory");
      else if (ahead == 1) asm volatile("s_waitcnt vmcnt(2)" ::: "memory");
      else asm volatile("s_waitcnt vmcnt(0)" ::: "memory");
    }
    __builtin_amdgcn_s_barrier();
    __builtin_amdgcn_sched_barrier(0);
    const char* kb_ = smem + (j % NS) * 16384;
    const char* vb_ = kb_ + 8192;
    const bool act = !latent || j >= nloc || (a0 + j >= rs && a0 + j <= rs + 7);
    if (act) {
      if (latent && j < nloc) {
        const char* bt = (const char*)rpbs + (a0 + j - row + 7) * 128;
        if (sw == 0) attn_tile<1>(kb_, vb_, bt, bi0, bi1, q0, q1, q2, q3, m, lsum, o0, o1, l32, hh, rsw);
        else attn_tile<2>(kb_, vb_, bt, bi0, bi1, q0, q1, q2, q3, m, lsum, o0, o1, l32, hh, rsw);
      } else {
        attn_tile<0>(kb_, vb_, nullptr, bi0, bi1, q0, q1, q2, q3, m, lsum, o0, o1, l32, hh, rsw);
      }
    }
  }
  __syncthreads();
  const float inv = 1.f / (lsum + __shfl_xor(lsum, 32));
  f16* op = (f16*)(P->ws + WS_H) + (size_t)(qtok0 + qc) * 1024 + h * 64;
#pragma unroll
  for (int q = 0; q < 4; ++q) {
    store4h(op + 8 * q + 4 * hh, o0[4 * q] * inv, o0[4 * q + 1] * inv, o0[4 * q + 2] * inv, o0[4 * q + 3] * inv);
    store4h(op + 32 + 8 * q + 4 * hh, o1[4 * q] * inv, o1[4 * q + 1] * inv, o1[4 * q + 2] * inv, o1[4 * q + 3] * inv);
  }
}

struct TileIter {
  int lt, step, nt, x;
  DI TileIter(int NT) {
    nt = NT;
    if (gridDim.x == 256) { x = blockIdx.x & 7; lt = blockIdx.x >> 3; step = 32; }
    else { x = -1; lt = blockIdx.x; step = gridDim.x; }
  }
  DI bool valid() const { return lt < (x >= 0 ? 10 * nt : 80 * nt); }
  DI int tm() const { return x >= 0 ? x + 8 * (lt / nt) : lt / nt; }
  DI int tn() const { return lt % nt; }
  DI void next() { lt += step; }
};

DI void phase_gin(KP P, char* smem) {
  const f16* hb = (const f16*)(P->ws + WS_H);
  const f16* w = (const f16*)(P->ws + WS_WIN);
  f16* u = (f16*)(P->ws + WS_B1);
  for (TileIter ti(6); ti.valid(); ti.next()) {
    const int tm = ti.tm(), tn = ti.tn();
    gemm8w<256, true, true>(smem, 1024, [&](int r) { return hb + (size_t)(tm * 256 + r) * 1024; },
              [&](int r) { return w + (size_t)(tn * 256 + r) * 1024; },
              [&](int m, int n, float v0, float v1, float v2, float v3) {
                const float4 bias = *(const float4*)(P->e_b_in + tn * 256 + n);
                return pack4h(v0 + bias.x, v1 + bias.y, v2 + bias.z, v3 + bias.w);
              }, [&](int m) { return u + (size_t)(tm * 256 + m) * 1536 + tn * 256; });
  }
}

DI void g1_tile(KP P, char* smem, int tile) {
  const int g = tile & 3, nt = (tile >> 2) & 1, mt = tile >> 3;
  const f16* u = (const f16*)(P->ws + WS_B1);
  const f16* fc = (const f16*)(P->ws + WS_FC);
  char* b2 = (char*)P->out;
  gemm_tile<true>(smem, 128,
            [&](int r) {
              const int m = mt * 256 + r;
              int tok = m;
              if (m >= TP) { const int lm = m - TP; tok = TP + (lm & ~4095) + ((lm >> 6) & 63) + 64 * (lm & 63); }
              return u + (size_t)tok * 1536 + 1024 + g * 128;
            },
            [&](int r) { return fc + (size_t)(nt * 128 + r) * 128; },
            [&](int m_, int n_, float v0, float v1, float v2, float v3) {
              const int m = mt * 256 + m_, n = nt * 128 + n_, l = n >> 1;
              f16* d;
              size_t ls, rs_;
              if (m < TP) {
                const int b = m >> 8, s_ = m & 255;
                d = (f16*)(b2 + B2_W1C) + ((size_t)((b * 4 + g) * 128 + l) * 512 + s_); ls = 512; rs_ = 256;
              } else {
                const int lm = m - TP, b = lm >> 12, s1 = (lm >> 6) & 63, s2 = lm & 63;
                d = (f16*)(b2 + B2_W1L) + ((size_t)(((b * 4 + g) * 128 + l) * 64 + s1) * 128 + s2); ls = 64 * 128; rs_ = 64;
              }
              d[0] = (f16)v0; d[rs_] = (f16)v1; d[ls] = (f16)v2; d[ls + rs_] = (f16)v3;
            });
}

DI void ct1_tile(KP P, char* smem, int mt) {
  char* b2 = (char*)P->out;
  const f16* w1l = (const f16*)(b2 + B2_W1L);
  const f16* f64 = (const f16*)(P->ws + WS_F64);
  f16* z = (f16*)(b2 + B2_Z);
  gemm_tile<true>(smem, 128, [&](int r) { return w1l + (size_t)(mt * 256 + r) * 128; }, [&](int r) { return f64 + (size_t)r * 128; },
            [&](int m_, int n, float v0, float v1, float v2, float v3) {
              const int m = mt * 256 + m_, bgl = m >> 6, s1 = m & 63, rip = n >> 6, k2 = n & 63;
              f16* d = z + ((size_t)(k2 * 2048 + bgl) * 128 + rip * 64 + s1);
              constexpr size_t ks = 2048ull * 128;
              d[0] = (f16)v0; d[ks] = (f16)v1; d[2 * ks] = (f16)v2; d[3 * ks] = (f16)v3;
            });
}

DI void ctxdft_tile(KP P, char* smem, int tile) {
  const int nt = tile & 1, mt = tile >> 1;
  char* b2 = (char*)P->out;
  const f16* w1c = (const f16*)(b2 + B2_W1C);
  const f16* dm = (const f16*)(P->ws + WS_D256);
  f16* yc = (f16*)(P->ws + WS_H);
  gemm_tile<true>(smem, 512, [&](int r) { return w1c + (size_t)(mt * 256 + r) * 512; },
            [&](int r) { return dm + (size_t)(nt * 128 + r) * 512; },
            [&](int m_, int n_, float v0, float v1, float v2, float v3) {
              const int m = mt * 256 + m_, k = nt * 128 + n_, b = m >> 9, g = (m >> 7) & 3, l = m & 127;
              f16* d = yc + (size_t)(b * 256 + k) * 1024 + 512 + g * 128 + l;
              d[0] = (f16)v0; d[1024] = (f16)v1; d[2048] = (f16)v2; d[3072] = (f16)v3;
            });
}

DI void ct2_tile(KP P, char* smem, int tile) {
  const int k2 = tile >> 3, mt = tile & 7;
  char* b2 = (char*)P->out;
  const f16* z = (const f16*)(b2 + B2_Z);
  const f16* dsm = (const f16*)(P->ws + WS_DS);
  f16* yc = (f16*)(P->ws + WS_H);
  gemm_tile<true>(smem, 128, [&](int r) { return z + (size_t)(k2 * 2048 + mt * 256 + r) * 128; },
            [&](int r) { return dsm + (size_t)(64 * (r & 63) + k2) * 128; },
            [&](int m_, int n, float v0, float v1, float v2, float v3) {
              if (n < 64) {
                const int m = mt * 256 + m_, b = m >> 9, g = (m >> 7) & 3, l = m & 127, k = 64 * n + k2;
                f16* d = yc + (size_t)(TP + b * 4096 + k) * 1024 + 512 + g * 128 + l;
                constexpr size_t ks = 64ull * 1024;
                d[0] = (f16)v0; d[ks] = (f16)v1; d[2 * ks] = (f16)v2; d[3 * ks] = (f16)v3;
              }
            });
}

template <bool FROM_INPUT>
DI void phase_proj(KP P, char* smem, const f16* w, const float* bias_, int layer, int gate_idx) {
  const f16* a = (const f16*)(P->ws + WS_H);
  f16* xr = (f16*)(P->ws + WS_XR);
  auto epi_at = [&](int t, int col, float v0, float v1, float v2, float v3) {
    const int cond = cond_of(t);
    const float4 bias = *(const float4*)(bias_ + col);
    const float4 gt = *(const float4*)((const float*)(P->ws + WS_ADAF) + (layer * 5 + cond) * 6144 + gate_idx * 1024 + col);
    float4 x;
    if (FROM_INPUT) {
      x = *(const float4*)((t < TP ? P->x_prompt + (size_t)t * 1024 : P->x_sample + (size_t)(t - TP) * 1024) + col);
    } else {
      const f16x4 q = *(const f16x4*)(xr + (size_t)t * 1024 + col);
      x.x = (float)q[0]; x.y = (float)q[1]; x.z = (float)q[2]; x.w = (float)q[3];
    }
    return pack4h(ALPHA * x.x + gt.x * (v0 + bias.x), ALPHA * x.y + gt.y * (v1 + bias.y),
                  ALPHA * x.z + gt.z * (v2 + bias.z), ALPHA * x.w + gt.w * (v3 + bias.w));
  };
  auto full_tile = [&](int tm, int tn) {
    gemm8w_n128(smem, 1024, [&](int r) { return a + (size_t)(tm * 256 + r) * 1024; },
                [&](int r) { return w + (size_t)(tn * 128 + r) * 1024; },
                [&](int m, int n, float v0, float v1, float v2, float v3) { return epi_at(tm * 256 + m, tn * 128 + n, v0, v1, v2, v3); },
                [&](int m) { return xr + (size_t)(tm * 256 + m) * 1024 + tn * 128; });
  };
  if (gridDim.x == 256) {
    const int x = blockIdx.x & 7, li = blockIdx.x >> 3;
    for (int lt = li; lt < 64; lt += 32) full_tile(x + 8 * (lt >> 3), lt & 7);
    const int tm = x + 8 * (8 + (li >> 4)), tn = (li & 15) >> 1, r0 = tm * 256 + (li & 1) * 128;
    gemm8w_m128(smem, 1024, [&](int r) { return a + (size_t)(r0 + r) * 1024; }, [&](int r) { return w + (size_t)(tn * 128 + r) * 1024; },
                [&](int m, int n, float v0, float v1, float v2, float v3) { return epi_at(r0 + m, tn * 128 + n, v0, v1, v2, v3); },
                [&](int m) { return xr + (size_t)(r0 + m) * 1024 + tn * 128; });
  } else {
    for (TileIter ti(8); ti.valid(); ti.next()) full_tile(ti.tm(), ti.tn());
  }
}

DI void phase_mlp1(KP P, char* smem, int layer) {
  const f16* a = (const f16*)(P->ws + WS_H);
  const f16* w = (const f16*)(P->ws + WS_W1) + (size_t)layer * 4096 * 1024;
  const float* bias_ = P->b1 + layer * 4096;
  for (TileIter ti(16); ti.valid(); ti.next()) {
    const int tm = ti.tm(), tn = ti.tn();
    f16* hid = tm * 256 < TH ? (f16*)P->out + (size_t)(tm * 256) * 4096 : (f16*)(P->ws + WS_B1) + (size_t)(tm * 256 - TH) * 4096;
    gemm8w<256, true, true>(smem, 1024, [&](int r) { return a + (size_t)(tm * 256 + r) * 1024; },
              [&](int r) { return w + (size_t)(tn * 256 + r) * 1024; },
              [&](int m, int n, float v0, float v1, float v2, float v3) {
                const float4 bias = *(const float4*)(bias_ + tn * 256 + n);
                v0 = fmaxf(v0 + bias.x, 0.f); v1 = fmaxf(v1 + bias.y, 0.f); v2 = fmaxf(v2 + bias.z, 0.f); v3 = fmaxf(v3 + bias.w, 0.f);
                return pack4h(v0 * v0, v1 * v1, v2 * v2, v3 * v3);
              }, [&](int m) { return hid + (size_t)m * 4096 + tn * 256; });
  }
}

DI void phase_mlp2(KP P, char* smem, int layer) {
  const f16* w = (const f16*)(P->ws + WS_W2) + (size_t)layer * 1024 * 4096;
  const float* bias_ = P->b2 + layer * 1024;
  f16* xr = (f16*)(P->ws + WS_XR);
  auto epi_at = [&](int t, int col, float v0, float v1, float v2, float v3) {
    const int cond = cond_of(t);
    const float4 bias = *(const float4*)(bias_ + col);
    const float4 gt = *(const float4*)((const float*)(P->ws + WS_ADAF) + (layer * 5 + cond) * 6144 + 5 * 1024 + col);
    f16* d = xr + (size_t)t * 1024 + col;
    const f16x4 q = *(const f16x4*)d;
    return pack4h(ALPHA * (float)q[0] + gt.x * (v0 + bias.x), ALPHA * (float)q[1] + gt.y * (v1 + bias.y),
                  ALPHA * (float)q[2] + gt.z * (v2 + bias.z), ALPHA * (float)q[3] + gt.w * (v3 + bias.w));
  };
  auto hid_row = [&](int t) { return t < TH ? (const f16*)P->out + (size_t)t * 4096 : (const f16*)(P->ws + WS_B1) + (size_t)(t - TH) * 4096; };
  auto full_tile = [&](int tm, int tn) {
    const f16* hid = hid_row(tm * 256);
    gemm8w_n128(smem, 4096, [&](int r) { return hid + (size_t)r * 4096; }, [&](int r) { return w + (size_t)(tn * 128 + r) * 4096; },
                [&](int m, int n, float v0, float v1, float v2, float v3) { return epi_at(tm * 256 + m, tn * 128 + n, v0, v1, v2, v3); },
                [&](int m) { return xr + (size_t)(tm * 256 + m) * 1024 + tn * 128; });
  };
  if (gridDim.x == 256) {
    const int x = blockIdx.x & 7, li = blockIdx.x >> 3;
    for (int lt = li; lt < 64; lt += 32) full_tile(x + 8 * (lt >> 3), lt & 7);
    const int tm = x + 8 * (8 + (li >> 4)), tn = (li & 15) >> 1, r0 = tm * 256 + (li & 1) * 128;
    const f16* hid = hid_row(r0);
    gemm8w_m128(smem, 4096, [&](int r) { return hid + (size_t)r * 4096; }, [&](int r) { return w + (size_t)(tn * 128 + r) * 4096; },
                [&](int m, int n, float v0, float v1, float v2, float v3) { return epi_at(r0 + m, tn * 128 + n, v0, v1, v2, v3); },
                [&](int m) { return xr + (size_t)(r0 + m) * 1024 + tn * 128; });
  } else {
    for (TileIter ti(8); ti.valid(); ti.next()) full_tile(ti.tm(), ti.tn());
  }
}

DI void qkv_tile(KP P, char* smem, int tile) {
  const int tm = tile / 12, tn = tile % 12;
  const f16* a = (const f16*)(P->ws + WS_H);
  const f16* w = (const f16*)(P->ws + WS_WQKV);
  f16* qbuf = (f16*)(P->ws + WS_B1);
  f16* kbuf = qbuf + (size_t)T * 1024;
  char* b2 = (char*)P->out;
  if (tn < 8) {
    gemm8w<256, true, true>(smem, 1024, [&](int r) { return a + (size_t)(tm * 256 + r) * 1024; },
              [&](int r) { return w + (size_t)(tn * 256 + r) * 1024; },
              [&](int m, int n, float v0, float v1, float v2, float v3) {
                const int col = tn * 256 + n, t = tm * 256 + m;
                const float4 bias = *(const float4*)(P->o_b_qkv + col);
                v0 += bias.x; v1 += bias.y; v2 += bias.z; v3 += bias.w;
                if (col < 1024) return pack4h(v0 * QSCALE, v1 * QSCALE, v2 * QSCALE, v3 * QSCALE);
                const int cc = col - 1024;
                if (t < TP) {
                  const int b = t >> 8, s = t & 255, hd = cc >> 6, dd = cc & 63;
                  float4 o; o.x = v0; o.y = v1; o.z = v2; o.w = v3;
                  *(float4*)(P->out + OUT_NK + ((size_t)((b * 16 + hd) * 256 + s) * 64 + dd)) = o;
                }
                return pack4h(v0, v1, v2, v3);
              }, [&](int m) { return (tn < 4 ? qbuf + tn * 256 : kbuf + (tn - 4) * 256) + (size_t)(tm * 256 + m) * 1024; });
  } else {
    gemm8w<256, false>(smem, 1024, [&](int r) { return a + (size_t)(tm * 256 + r) * 1024; },
              [&](int r) { return w + (size_t)(tn * 256 + r) * 1024; },
              [&](int m, int n, float v0, float v1, float v2, float v3) {
                const int col = tn * 256 + n, t = tm * 256 + m;
                const float bias = P->o_b_qkv[col];
                v0 += bias; v1 += bias; v2 += bias; v3 += bias;
                const int cc = col - 2048, hd = cc >> 6, dd = cc & 63;
                if (t < TP) {
                  const int b = t >> 8, s = t & 255;
                  store4h((f16*)(b2 + B2_VTC) + ((size_t)((b * 16 + hd) * 64 + dd) * 256 + s), v0, v1, v2, v3);
                  float* o = P->out + OUT_NV + ((size_t)((b * 16 + hd) * 256 + s) * 64 + dd);
                  o[0] = v0; o[64] = v1; o[128] = v2; o[192] = v3;
                } else {
                  const int lt = t - TP, b = lt >> 12, s = lt & 4095;
                  store4h((f16*)(b2 + B2_VTL) + ((size_t)((b * 16 + hd) * 64 + dd) * 4096 + s), v0, v1, v2, v3);
                }
              });
  }
}

DI void phase_qkv(KP P, char* smem) {
  constexpr int NG = 80 * 12, NCK = 256, NCV = 512;
  char* b2 = (char*)P->out;
  for (TileIter ti(12); ti.valid(); ti.next()) qkv_tile(P, smem, ti.tm() * 12 + ti.tn());
  char* hsm = smem + half_() * kHalfLds;
  int it0 = blockIdx.x * 2 + half_(), itstep = gridDim.x * 2;
  if (gridDim.x == 256) {
    const int li = blockIdx.x >> 3;
    if (li >= 24) { it0 = (((li - 24) * 8 + (blockIdx.x & 7)) * 2) + half_(); itstep = 128; } else { it0 = NCK + NCV; }
  }
  for (int it = it0; it < NCK + NCV; it += itstep) {
    if (it < NCK) {
      const int i0 = it * 8192;
      f16* ck = (f16*)(b2 + B2_CK);
#pragma unroll
      for (int j = 0; j < 8; ++j) {
        const int e = i0 + (j * 256 + tid_()) * 4;
        const float4 v = *(const float4*)(P->cache_k + e);
        store4h(ck + e, v.x, v.y, v.z, v.w);
      }
    } else {
      const int i = it - NCK, bh = i >> 3, kt = i & 7;
      tconv_tile(hsm, P->cache_v + (size_t)bh * 512 * 64, 64, (f16*)(b2 + B2_CVT) + (size_t)bh * 64 * 512, 512, kt * 64, 0);
    }
  }
}

#define XB_TMO      128
#define XB_XCNT(j)  (256  + 64 * (j))
#define XB_XSUB(j)  (1280 + 64 * (j))
#define XB_XGEN(j)  (2304 + 64 * (j))
#define XB_TOP      3328
#define XB_TOPGEN   3392
#define XCD_BAR_WORDS 3456
#define XB_SPIN_CAP (1u << 18)
DI unsigned xb_ld(unsigned* p) { return __hip_atomic_load(p, __ATOMIC_RELAXED, __HIP_MEMORY_SCOPE_AGENT); }
DI unsigned xb_add(unsigned* p, unsigned v) { return __hip_atomic_fetch_add(p, v, __ATOMIC_RELAXED, __HIP_MEMORY_SCOPE_AGENT); }
DI unsigned xb_xcc_id() { return (unsigned)__builtin_amdgcn_s_getreg((3 << 11) | 20) & 0xFu; }
#define XB_SPIN(cond, bar) do { unsigned _sp = 0; while (cond) { __builtin_amdgcn_s_sleep(1); \
    if ((++_sp & 255u) == 0u) { if (xb_ld(&(bar)[XB_TMO])) break; if (_sp > XB_SPIN_CAP) { atomicAdd(&(bar)[XB_TMO], 1u); break; } } } } while (0)
struct XcdBarrier { unsigned* bar; unsigned x; volatile LAS unsigned* st; };
DI XcdBarrier xcd_barrier_post(unsigned* bar, volatile LAS unsigned* st) {
  XcdBarrier b; b.bar = bar; b.x = xb_xcc_id(); b.st = st;
  if (threadIdx.x == 0) (void)xb_add(&bar[XB_XCNT(b.x)], 1u);
  return b;
}
DI void xcd_barrier_complete(unsigned* bar, unsigned x, unsigned& nloc, unsigned& nx) {
  const unsigned G = gridDim.x * gridDim.y * gridDim.z;
  unsigned sum, cnt, mine, sp = 0u;
  for (;;) {
    sum = 0u; cnt = 0u; mine = 0u;
#pragma unroll
    for (unsigned j = 0; j < 16; ++j) { const unsigned c = xb_ld(&bar[XB_XCNT(j)]); sum += c; cnt += (c > 0u) ? 1u : 0u; mine = (j == x) ? c : mine; }
    if (sum == G) break;
    __builtin_amdgcn_s_sleep(1);
    if ((++sp & 255u) == 0u) { if (xb_ld(&bar[XB_TMO])) break; if (sp > XB_SPIN_CAP) { atomicAdd(&bar[XB_TMO], 1u); break; } }
  }
  nloc = mine > 0u ? mine : 1u; nx = cnt > 0u ? cnt : 1u;
}
DI void xcd_barrier(const XcdBarrier& b) {
  asm volatile("s_waitcnt vmcnt(0)" ::: "memory");
  __syncthreads();
  if (threadIdx.x == 0) {
    unsigned* bar = b.bar;
    __builtin_amdgcn_s_waitcnt(0);
    unsigned nloc = b.st[0], nx = b.st[1];
    if (nloc == 0u) { xcd_barrier_complete(bar, b.x, nloc, nx); b.st[0] = nloc; b.st[1] = nx; }
    const unsigned old = xb_add(&bar[XB_XSUB(b.x)], 1u);
    const unsigned gen = old / nloc;
    if (old + 1u == (gen + 1u) * nloc) {
      __builtin_amdgcn_fence(__ATOMIC_RELEASE, "agent");
      asm volatile("s_waitcnt vmcnt(0)" ::: "memory");
      const unsigned og = xb_add(&bar[XB_TOP], 1u);
      const unsigned tg = og / nx;
      if (og + 1u == (tg + 1u) * nx) xb_add(&bar[XB_TOPGEN], 1u);
      else XB_SPIN(xb_ld(&bar[XB_TOPGEN]) == tg, bar);
      __builtin_amdgcn_fence(__ATOMIC_ACQUIRE, "agent");
      xb_add(&bar[XB_XGEN(b.x)], 1u);
      asm volatile("s_waitcnt vmcnt(0)" ::: "memory");
    } else {
      XB_SPIN(xb_ld(&bar[XB_XGEN(b.x)]) == gen, bar);
      __builtin_amdgcn_fence(__ATOMIC_ACQUIRE, "agent");
      asm volatile("s_waitcnt vmcnt(0)" ::: "memory");
    }
  }
  __syncthreads();
}

enum { PH_PREP = 0, PH_LN0, PH_GIN, PH_SCAN0, PH_SCAN1, PH_CT2, PH_OUT0, PH_LN1, PH_MLP1A, PH_MLP2A, PH_LN2, PH_QKV, PH_ATT,
       PH_OUT1, PH_LN3, PH_MLP1B, PH_MLP2B, PH_LN4, NPH };

__global__ void __launch_bounds__(512, 2) mk(Params PP) {
  extern __shared__ __attribute__((aligned(16))) char smem[];
  cg::grid_group grid = cg::this_grid();
  __shared__ uint4 xb_words;
  if (threadIdx.x == 0) xb_words = make_uint4(0u, 0u, 0u, 0u);
  __syncthreads();
  const XcdBarrier xb = xcd_barrier_post((unsigned*)(PP.ws + WS_BAR), (volatile LAS unsigned*)&xb_words);
  const int phase_hi = PP.phase_hi;
  if (phase_hi > 1000) grid.sync();
  for (int ph = PP.phase_lo; ph < phase_hi; ++ph) {
   const int reps = (ph == REP_PHASE) ? 2 : 1;
   for (int rep = 0; rep < reps; ++rep) {
    KP P = (KP)__builtin_amdgcn_kernarg_segment_ptr();
    asm volatile("" : "+s"(P));
    switch (ph) {
      case PH_PREP: phase_prep(P, smem); break;
      case PH_LN0: phase_ln<true, false, true, false>(P, nullptr, nullptr, 0, 0, 1); break;
      case PH_GIN: phase_gin(P, smem); break;
      case PH_SCAN0:
        for (int it = blockIdx.x * 2 + half_(); it < 2560 + 640; it += gridDim.x * 2) {
          char* hsm = smem + half_() * kHalfLds;
          if (it < 2560) scan_item(P, hsm, it, 0); else g1_tile(P, hsm, it - 2560);
        }
        break;
      case PH_SCAN1:
        for (int it = blockIdx.x * 2 + half_(); it < 64 + 2560 + 512; it += gridDim.x * 2) {
          char* hsm = smem + half_() * kHalfLds;
          if (it < 64) ctxdft_tile(P, hsm, it);
          else if (it < 64 + 2560) scan_item(P, hsm, it - 64, 1);
          else ct1_tile(P, hsm, it - 64 - 2560);
        }
        break;
      case PH_CT2:
        for (int it = blockIdx.x * 2 + half_(); it < 512; it += gridDim.x * 2) ct2_tile(P, smem + half_() * kHalfLds, it);
        break;
      case PH_OUT0: phase_proj<true>(P, smem, (const f16*)(P->ws + WS_WOUT0), P->e_b_out, 0, 2); break;
      case PH_LN1: phase_ln<false, true, true, false>(P, P->ln1_g, P->ln1_b, 0, 3, 4); break;
      case PH_MLP1A: phase_mlp1(P, smem, 0); break;
      case PH_MLP2A: phase_mlp2(P, smem, 0); break;
      case PH_LN2: phase_ln<false, true, true, false>(P, P->ln2_g, P->ln2_b, 1, 0, 1); break;
      case PH_QKV: phase_qkv(P, smem); break;
      case PH_ATT:
        for (int it = blockIdx.x; it < 1280; it += gridDim.x) {
          int item = it;
          if (it < 1024 && gridDim.x == 256) {
            const int x = blockIdx.x & 7, li = blockIdx.x >> 3, r = it >> 8;
            item = (r * 16 + 2 * x + (li >> 4)) * 16 + (li & 15);
          }
          attn_item(P, smem, item);
        }
        break;
      case PH_OUT1: phase_proj<false>(P, smem, (const f16*)(P->ws + WS_WO1), P->o_b_out, 1, 2); break;
      case PH_LN3: phase_ln<false, true, true, false>(P, P->ln1_g + 1024, P->ln1_b + 1024, 1, 3, 4); break;
      case PH_MLP1B: phase_mlp1(P, smem, 1); break;
      case PH_MLP2B: phase_mlp2(P, smem, 1); break;
      case PH_LN4: phase_ln<false, true, false, true>(P, P->ln2_g + 1024, P->ln2_b + 1024, 1, 0, 0); break;
    }
    if (ph + 1 < phase_hi || rep + 1 < reps) xcd_barrier(xb);
   }
  }
}

extern "C" void kernel_launch(void* const* d_in, const int* in_sizes, int n_in, void* d_out, int out_size, void* d_ws,
                              size_t ws_size, hipStream_t stream) {
  static int grid_blocks = 0;
  if (!grid_blocks) {
    hipFuncSetAttribute((const void*)mk, hipFuncAttributeMaxDynamicSharedMemorySize, kLds);
    int dev = 0, cus = 0, per_cu = 0;
    hipGetDevice(&dev);
    hipDeviceGetAttribute(&cus, hipDeviceAttributeMultiprocessorCount, dev);
    hipOccupancyMaxActiveBlocksPerMultiprocessor(&per_cu, mk, 512, kLds);
    if (per_cu > 1) per_cu = 1;
    grid_blocks = cus * per_cu;
  }
  Params p{};
  const float** pp = (const float**)&p;
  for (int i = 0; i < 33; ++i) pp[i] = (const float*)d_in[i];
  p.out = (float*)d_out;
  p.ws = (char*)d_ws;
  p.phase_lo = 0;
  p.phase_hi = NPH;
  if (ws_size < WS_END) { fprintf(stderr, "workspace too small: %zu < %zu\n", ws_size, (size_t)WS_END); return; }
  hipMemsetAsync((char*)d_ws + WS_BAR, 0, XCD_BAR_WORDS * 4, stream);
  void* args[] = {&p};
  hipError_t e = hipLaunchCooperativeKernel((const void*)mk, dim3(grid_blocks), dim3(512), args, kLds, stream);
  if (e != hipSuccess) fprintf(stderr, "cooperative launch failed: %s (grid %d)\n", hipGetErrorString(e), grid_blocks);
}
```

```cpp
#include <hip/hip_runtime.h>
#include <hip/hip_cooperative_groups.h>
#include <cstdio>
namespace cg = cooperative_groups;

typedef _Float16 f16;
typedef __attribute__((ext_vector_type(8))) _Float16 f16x8;
typedef __attribute__((ext_vector_type(4))) _Float16 f16x4;
typedef __attribute__((ext_vector_type(16))) float f32x16;
#define DI __device__ __forceinline__
#define LAS __attribute__((address_space(3)))
#define MFMA(a, b, c) __builtin_amdgcn_mfma_f32_32x32x16_f16((a), (b), (c), 0, 0, 0)

constexpr int T = 20480;
constexpr int TP = 4096;
constexpr int TH = 10240;
constexpr float ALPHA = 1.41421356237f;
constexpr float LOG2E = 1.4426950408889634f;
constexpr float QSCALE = 0.125f * LOG2E;
constexpr int kLds = 147456;
#define REP_PHASE -1

constexpr size_t WS_WIN = 0;
constexpr size_t WS_WOUT0 = WS_WIN + 1536ull * 1024 * 2;
constexpr size_t WS_W1 = WS_WOUT0 + 1024ull * 1024 * 2;
constexpr size_t WS_W2 = WS_W1 + 2ull * 4096 * 1024 * 2;
constexpr size_t WS_WQKV = WS_W2 + 2ull * 4096 * 1024 * 2;
constexpr size_t WS_WO1 = WS_WQKV + 3072ull * 1024 * 2;
constexpr size_t WS_GW = WS_WO1 + 1024ull * 1024 * 2;
constexpr size_t WS_FC = WS_GW + 32ull * 4096 * 2;
constexpr size_t WS_D256 = WS_FC + 256ull * 128 * 2;
constexpr size_t WS_F64 = WS_D256 + 256ull * 512 * 2;
constexpr size_t WS_DS = WS_F64 + 128ull * 128 * 2;
constexpr size_t WS_ADAP = WS_DS + 4096ull * 128 * 2;
constexpr size_t WS_SUM = WS_ADAP + 2ull * 4 * 5 * 6144 * 4;
constexpr size_t WS_XR = WS_SUM + 320ull * 2 * 512 * 8;
constexpr size_t WS_H = WS_XR + (size_t)T * 1024 * 4;
constexpr size_t WS_B1 = WS_H + (size_t)T * 1024 * 2;
constexpr size_t WS_BAR = WS_B1 + (size_t)T * 1024 * 4;
constexpr size_t WS_ADAF = WS_BAR + 3456 * 4;
constexpr size_t WS_END = WS_ADAF + 2ull * 5 * 6144 * 4;
constexpr size_t B2_W1C = 0;
constexpr size_t B2_W1L = 8388608;
constexpr size_t B2_Z = 41943040;
constexpr size_t B2_VTC = 0;
constexpr size_t B2_VTL = 8388608;
constexpr size_t B2_CK = 41943040;
constexpr size_t B2_CVT = 46137344;
constexpr size_t OUT_LRU = (size_t)T * 1024;
constexpr size_t OUT_NK = OUT_LRU + 16 * 2 * 512;
constexpr size_t OUT_NV = OUT_NK + 16ull * 16 * 256 * 64;

struct Params {
  const float *x_prompt, *x_sample, *c, *state_lru, *cache_k, *cache_v, *c_ctx, *ada_w, *ada_b, *ln1_g, *ln1_b, *ln2_g,
      *ln2_b, *w1, *b1, *w2, *b2, *e_w_in, *e_b_in, *e_conv_w, *e_conv_b, *e_w_r, *e_b_r, *e_w_i, *e_b_i, *e_lam,
      *e_w_out, *e_b_out, *o_w_qkv, *o_b_qkv, *o_rpb, *o_w_out, *o_b_out;
  float* out;
  char* ws;
  int phase_lo, phase_hi;
};

typedef const __attribute__((address_space(4))) Params* KP;
DI int tidf_() { int t = threadIdx.x; asm volatile("" : "+v"(t)); return t; }
DI int tid_() { return tidf_() & 255; }
DI int half_() { return __builtin_amdgcn_readfirstlane((int)(threadIdx.x >> 8)); }
constexpr int kHalfLds = 73728;
DI int crow(int reg, int hh) { return (reg & 3) + 8 * (reg >> 2) + 4 * hh; }
DI float wave_sum(float v) {
#pragma unroll
  for (int o = 32; o; o >>= 1) v += __shfl_xor(v, o);
  return v;
}
DI float sigmoidf_(float x) { return __builtin_amdgcn_rcpf(1.f + __expf(-x)); }
DI float one_minus_exp(float x) {
  const float p = -x * (1.f + x * (0.5f + x * (0.16666667f + x * (0.041666668f + x * (0.0083333338f + x * 0.0013888889f)))));
  return x > -0.25f ? p : 1.f - __expf(x);
}
DI float ada_val(KP P, int layer, int cond, int idx) {
  const float* adap = (const float*)(P->ws + WS_ADAP);
  float s = P->ada_b[layer * 6144 + idx];
#pragma unroll
  for (int kc = 0; kc < 4; ++kc) s += adap[((layer * 4 + kc) * 5 + cond) * 6144 + idx];
  return s;
}
DI float adaf(KP P, int layer, int cond, int idx) { return ((const float*)(P->ws + WS_ADAF))[(layer * 5 + cond) * 6144 + idx]; }
DI int cond_of(int t) { return t < TP ? 0 : 1 + ((t - TP) >> 12); }

template <bool TR = false, int VAR = 0, class AF, class BF, class EF>
DI void gemm_tile(char* smem, int K, AF arow, BF brow, EF epi) {
  const int tid = tid_(), lane = tid & 63, wave = tid >> 6;
  const int wm = wave >> 1, wn = wave & 1, l32 = lane & 31, hh = lane >> 5;
  const int lr = lane >> 2, lc = ((lane & 3) ^ ((lane >> 4) & 3)) * 8;
  const f16* ap0 = arow(wave * 64 + lr) + lc;
  const f16* ap1 = arow(wave * 64 + 16 + lr) + lc;
  const f16* ap2 = arow(wave * 64 + 32 + lr) + lc;
  const f16* ap3 = arow(wave * 64 + 48 + lr) + lc;
  const f16* bp0 = brow(wave * 32 + lr) + lc;
  const f16* bp1 = brow(wave * 32 + 16 + lr) + lc;
  const int dA = wave * 4096 + lane * 16, dB = 16384 + wave * 2048 + lane * 16;
#define DMA(stage_off, ko)                                                                                       \
  __builtin_amdgcn_global_load_lds((const void*)(ap0 + (ko)), (LAS void*)(smem + (stage_off) + dA), 16, 0, 0);          \
  __builtin_amdgcn_global_load_lds((const void*)(ap1 + (ko)), (LAS void*)(smem + (stage_off) + dA + 1024), 16, 0, 0);   \
  __builtin_amdgcn_global_load_lds((const void*)(ap2 + (ko)), (LAS void*)(smem + (stage_off) + dA + 2048), 16, 0, 0);   \
  __builtin_amdgcn_global_load_lds((const void*)(ap3 + (ko)), (LAS void*)(smem + (stage_off) + dA + 3072), 16, 0, 0);   \
  __builtin_amdgcn_global_load_lds((const void*)(bp0 + (ko)), (LAS void*)(smem + (stage_off) + dB), 16, 0, 0);          \
  __builtin_amdgcn_global_load_lds((const void*)(bp1 + (ko)), (LAS void*)(smem + (stage_off) + dB + 1024), 16, 0, 0);
  const int nk = K >> 5;
  DMA(0, 0)
  DMA(24576, 32)
  asm volatile("s_waitcnt vmcnt(6)" ::: "memory");
  __builtin_amdgcn_s_barrier();
  f32x16 acc[4][2];
#pragma unroll
  for (int i = 0; i < 4; ++i)
#pragma unroll
    for (int j = 0; j < 2; ++j)
#pragma unroll
      for (int e = 0; e < 16; ++e) acc[i][j][e] = 0.f;
  const int rsw = (l32 >> 2) & 3;
  const int aoff = (wm * 128 + l32) * 64, boff = 16384 + (wn * 64 + l32) * 64;
  int cur = 0, nxt = 49152;
  for (int kt = 0; kt < nk; ++kt) {
    if (kt + 2 < nk) { const int kk = kt + 2; DMA(nxt, (VAR == 1 ? 0 : VAR == 3 ? ((((kk >> 1) ^ lr) << 6) + (kk & 1) * 32) : kk * 32)) }
    const char* st = smem + cur;
    {
      const int co0 = ((0 + hh) ^ rsw) << 4, co1 = ((2 + hh) ^ rsw) << 4;
      f16x8 a0[4], b0[2], a1[4], b1[2];
#pragma unroll
      for (int j = 0; j < 2; ++j) b0[j] = *(const f16x8*)(st + boff + j * 2048 + co0);
#pragma unroll
      for (int i = 0; i < 4; ++i) a0[i] = *(const f16x8*)(st + aoff + i * 2048 + co0);
#pragma unroll
      for (int j = 0; j < 2; ++j) b1[j] = *(const f16x8*)(st + boff + j * 2048 + co1);
#pragma unroll
      for (int i = 0; i < 4; ++i) a1[i] = *(const f16x8*)(st + aoff + i * 2048 + co1);
      __builtin_amdgcn_sched_barrier(0);
      if (VAR == 2) { acc[0][0][0] += (float)a0[0][0] + (float)b0[0][0] + (float)a1[3][0] + (float)b1[1][0]; } else {
#pragma unroll
      for (int i = 0; i < 4; ++i)
#pragma unroll
        for (int j = 0; j < 2; ++j) acc[i][j] = TR ? MFMA(b0[j], a0[i], acc[i][j]) : MFMA(a0[i], b0[j], acc[i][j]);
#pragma unroll
      for (int i = 0; i < 4; ++i)
#pragma unroll
        for (int j = 0; j < 2; ++j) acc[i][j] = TR ? MFMA(b1[j], a1[i], acc[i][j]) : MFMA(a1[i], b1[j], acc[i][j]);
      }
      __builtin_amdgcn_sched_barrier(0);
    }
    if (kt + 2 < nk) asm volatile("s_waitcnt vmcnt(6)" ::: "memory");
    else asm volatile("s_waitcnt vmcnt(0)" ::: "memory");
    __builtin_amdgcn_s_barrier();
    cur = cur == 49152 ? 0 : cur + 24576;
    nxt = nxt == 49152 ? 0 : nxt + 24576;
  }
#undef DMA
#pragma unroll
  for (int i = 0; i < 4; ++i)
#pragma unroll
    for (int j = 0; j < 2; ++j)
#pragma unroll
      for (int q = 0; q < 4; ++q)
        if (TR) epi(wm * 128 + i * 32 + l32, wn * 64 + j * 32 + 8 * q + 4 * hh, acc[i][j][4 * q], acc[i][j][4 * q + 1], acc[i][j][4 * q + 2], acc[i][j][4 * q + 3]);
        else epi(wm * 128 + i * 32 + 8 * q + 4 * hh, wn * 64 + j * 32 + l32, acc[i][j][4 * q], acc[i][j][4 * q + 1], acc[i][j][4 * q + 2], acc[i][j][4 * q + 3]);
}

template <int BN, bool TR, bool PK = false, class AF, class BF, class EF, class RF = int>
DI void gemm8w(char* smem, int K, AF arow, BF brow, EF epi, RF rowptr = 0) {
  constexpr int WN = BN / 64, WM = 8 / WN, MI = 256 / (WM * 32), NB = BN / 128;
  constexpr int STG = 16384 + BN * 64;
  const int tid = tidf_(), lane = tid & 63, wave = tid >> 6;
  const int grp = __builtin_amdgcn_readfirstlane(wave >> 2);
  const int wm = wave / WN, wn = wave % WN, l32 = lane & 31, hh = lane >> 5;
  const int lr = lane >> 2, lc = ((lane & 3) ^ ((lane >> 4) & 3)) * 8;
  const f16* ap0 = arow(wave * 32 + lr) + lc;
  const f16* ap1 = arow(wave * 32 + 16 + lr) + lc;
  const f16* bp0 = brow(wave * (16 * NB) + lr) + lc;
  const f16* bp1 = NB == 2 ? brow(wave * 32 + 16 + lr) + lc : bp0;
  const int dA = wave * 2048 + lane * 16, dB = 16384 + wave * (1024 * NB) + lane * 16;
#define DMA4(stage_off, ko)                                                                                              \
  __builtin_amdgcn_global_load_lds((const void*)(ap0 + (ko)), (LAS void*)(smem + (stage_off) + dA), 16, 0, 0);          \
  __builtin_amdgcn_global_load_lds((const void*)(ap1 + (ko)), (LAS void*)(smem + (stage_off) + dA + 1024), 16, 0, 0);   \
  __builtin_amdgcn_global_load_lds((const void*)(bp0 + (ko)), (LAS void*)(smem + (stage_off) + dB), 16, 0, 0);          \
  if (NB == 2) __builtin_amdgcn_global_load_lds((const void*)(bp1 + (ko)), (LAS void*)(smem + (stage_off) + dB + 1024), 16, 0, 0);
  const int nk = K >> 5;
  DMA4(0, 0)
  DMA4(STG, 32)
  DMA4(2 * STG, 64)
  if (NB == 2) asm volatile("s_waitcnt vmcnt(8)" ::: "memory"); else asm volatile("s_waitcnt vmcnt(6)" ::: "memory");
  __builtin_amdgcn_s_barrier();
  if (grp == 1) __builtin_amdgcn_s_barrier();
  f32x16 acc[MI][2];
#pragma unroll
  for (int i = 0; i < MI; ++i)
#pragma unroll
    for (int j = 0; j < 2; ++j)
#pragma unroll
      for (int e = 0; e < 16; ++e) acc[i][j][e] = 0.f;
  const int rsw = (l32 >> 2) & 3;
  const int aoff = (wm * (MI * 32) + l32) * 64, boff = 16384 + (wn * 64 + l32) * 64;
  const int co0 = ((0 + hh) ^ rsw) << 4, co1 = ((2 + hh) ^ rsw) << 4;
  int cur = 0, nxt = 3 * STG;
  for (int kt = 0; kt < nk; ++kt) {
    if (kt + 3 < nk) { DMA4(nxt, (kt + 3) * 32) }
    const char* st = smem + cur;
    f16x8 a0[MI], b0[2], a1[MI], b1[2];
#pragma unroll
    for (int j = 0; j < 2; ++j) b0[j] = *(const f16x8*)(st + boff + j * 2048 + co0);
#pragma unroll
    for (int i = 0; i < MI; ++i) a0[i] = *(const f16x8*)(st + aoff + i * 2048 + co0);
#pragma unroll
    for (int j = 0; j < 2; ++j) b1[j] = *(const f16x8*)(st + boff + j * 2048 + co1);
#pragma unroll
    for (int i = 0; i < MI; ++i) a1[i] = *(const f16x8*)(st + aoff + i * 2048 + co1);
    __builtin_amdgcn_sched_barrier(0);
    if (kt + 3 < nk) {
      if (NB == 2) asm volatile("s_waitcnt vmcnt(8) lgkmcnt(0)" ::: "memory"); else asm volatile("s_waitcnt vmcnt(6) lgkmcnt(0)" ::: "memory");
    } else {
      asm volatile("s_waitcnt vmcnt(0) lgkmcnt(0)" ::: "memory");
    }
    __builtin_amdgcn_s_barrier();
    __builtin_amdgcn_sched_barrier(0);
#pragma unroll
    for (int i = 0; i < MI; ++i)
#pragma unroll
      for (int j = 0; j < 2; ++j) acc[i][j] = TR ? MFMA(b0[j], a0[i], acc[i][j]) : MFMA(a0[i], b0[j], acc[i][j]);
#pragma unroll
    for (int i = 0; i < MI; ++i)
#pragma unroll
      for (int j = 0; j < 2; ++j) acc[i][j] = TR ? MFMA(b1[j], a1[i], acc[i][j]) : MFMA(a1[i], b1[j], acc[i][j]);
    __builtin_amdgcn_sched_barrier(0);
    __builtin_amdgcn_s_barrier();
    __builtin_amdgcn_sched_barrier(0);
    cur = cur == 3 * STG ? 0 : cur + STG;
    nxt = nxt == 3 * STG ? 0 : nxt + STG;
  }
  if (grp == 0) __builtin_amdgcn_s_barrier();
#undef DMA4
  if constexpr (PK) {
#pragma unroll
    for (int i = 0; i < MI; ++i)
#pragma unroll
      for (int j = 0; j < 2; ++j)
#pragma unroll
        for (int q = 0; q < 4; q += 2) {
          const int m = wm * (MI * 32) + i * 32 + l32, n = wn * 64 + j * 32 + 8 * q;
          const uint2 pa = epi(m, n + 4 * hh, acc[i][j][4 * q], acc[i][j][4 * q + 1], acc[i][j][4 * q + 2], acc[i][j][4 * q + 3]);
          const uint2 pb = epi(m, n + 8 + 4 * hh, acc[i][j][4 * q + 4], acc[i][j][4 * q + 5], acc[i][j][4 * q + 6], acc[i][j][4 * q + 7]);
          store_pair16(rowptr(m) + n, pa, pb, hh);
        }
  } else
#pragma unroll
  for (int i = 0; i < MI; ++i)
#pragma unroll
    for (int j = 0; j < 2; ++j)
#pragma unroll
      for (int q = 0; q < 4; ++q)
        if (TR) epi(wm * (MI * 32) + i * 32 + l32, wn * 64 + j * 32 + 8 * q + 4 * hh, acc[i][j][4 * q], acc[i][j][4 * q + 1], acc[i][j][4 * q + 2], acc[i][j][4 * q + 3]);
        else epi(wm * (MI * 32) + i * 32 + 8 * q + 4 * hh, wn * 64 + j * 32 + l32, acc[i][j][4 * q], acc[i][j][4 * q + 1], acc[i][j][4 * q + 2], acc[i][j][4 * q + 3]);
}

template <class AF, class BF, class EF, class RF>
DI void gemm8w_n128(char* smem, int K, AF arow, BF brow, EF epi, RF rowptr) {
  constexpr int STG = 24576;
  const int tid = tidf_(), lane = tid & 63, wave = tid >> 6;
  const int grp = __builtin_amdgcn_readfirstlane(wave >> 2);
  const int wm = wave >> 1, wn = wave & 1, l32 = lane & 31, hh = lane >> 5;
  const int lr = lane >> 2, lc = ((lane & 3) ^ ((lane >> 4) & 3)) * 8;
  const f16* ap0 = arow(wave * 32 + lr) + lc;
  const f16* ap1 = arow(wave * 32 + 16 + lr) + lc;
  const f16* bp0 = brow(wave * 16 + lr) + lc;
  const int dA = wave * 2048 + lane * 16, dB = 16384 + wave * 1024 + lane * 16;
#define DMA3(stage_off, ko)                                                                                              \
  __builtin_amdgcn_global_load_lds((const void*)(ap0 + (ko)), (LAS void*)(smem + (stage_off) + dA), 16, 0, 0);          \
  __builtin_amdgcn_global_load_lds((const void*)(ap1 + (ko)), (LAS void*)(smem + (stage_off) + dA + 1024), 16, 0, 0);   \
  __builtin_amdgcn_global_load_lds((const void*)(bp0 + (ko)), (LAS void*)(smem + (stage_off) + dB), 16, 0, 0);
  const int nk = K >> 5;
  DMA3(0, 0)
  DMA3(STG, 32)
  DMA3(2 * STG, 64)
  DMA3(3 * STG, 96)
  asm volatile("s_waitcnt vmcnt(6)" ::: "memory");
  __builtin_amdgcn_s_barrier();
  if (grp == 1) __builtin_amdgcn_s_barrier();
  f32x16 acc[2][2];
#pragma unroll
  for (int i = 0; i < 2; ++i)
#pragma unroll
    for (int j = 0; j < 2; ++j)
#pragma unroll
      for (int e = 0; e < 16; ++e) acc[i][j][e] = 0.f;
  const int rsw = (l32 >> 2) & 3;
  const int aoff = (wm * 64 + l32) * 64, boff = 16384 + (wn * 64 + l32) * 64;
  const int co0 = ((0 + hh) ^ rsw) << 4, co1 = ((2 + hh) ^ rsw) << 4;
  int cur = 0, nxt = 4 * STG;
  for (int kt = 0; kt < nk; kt += 2) {
    if (kt + 4 < nk) { DMA3(nxt, (kt + 4) * 32) DMA3(nxt + STG, (kt + 5) * 32) }
    const char* st = smem + cur;
    f16x8 a0[2], b0[2], a1[2], b1[2], a2[2], b2[2], a3[2], b3[2];
#pragma unroll
    for (int j = 0; j < 2; ++j) { b0[j] = *(const f16x8*)(st + boff + j * 2048 + co0); b1[j] = *(const f16x8*)(st + boff + j * 2048 + co1); }
#pragma unroll
    for (int i = 0; i < 2; ++i) { a0[i] = *(const f16x8*)(st + aoff + i * 2048 + co0); a1[i] = *(const f16x8*)(st + aoff + i * 2048 + co1); }
#pragma unroll
    for (int j = 0; j < 2; ++j) { b2[j] = *(const f16x8*)(st + STG + boff + j * 2048 + co0); b3[j] = *(const f16x8*)(st + STG + boff + j * 2048 + co1); }
#pragma unroll
    for (int i = 0; i < 2; ++i) { a2[i] = *(const f16x8*)(st + STG + aoff + i * 2048 + co0); a3[i] = *(const f16x8*)(st + STG + aoff + i * 2048 + co1); }
    __builtin_amdgcn_sched_barrier(0);
    if (kt + 4 < nk) asm volatile("s_waitcnt vmcnt(6) lgkmcnt(0)" ::: "memory");
    else asm volatile("s_waitcnt vmcnt(0) lgkmcnt(0)" ::: "memory");
    __builtin_amdgcn_s_barrier();
    __builtin_amdgcn_sched_barrier(0);
#pragma unroll
    for (int i = 0; i < 2; ++i)
#pragma unroll
      for (int j = 0; j < 2; ++j) acc[i][j] = MFMA(b0[j], a0[i], acc[i][j]);
#pragma unroll
    for (int i = 0; i < 2; ++i)
#pragma unroll
      for (int j = 0; j < 2; ++j) acc[i][j] = MFMA(b1[j], a1[i], acc[i][j]);
#pragma unroll
    for (int i = 0; i < 2; ++i)
#pragma unroll
      for (int j = 0; j < 2; ++j) acc[i][j] = MFMA(b2[j], a2[i], acc[i][j]);
#pragma unroll
    for (int i = 0; i < 2; ++i)
#pragma unroll
      for (int j = 0; j < 2; ++j) acc[i][j] = MFMA(b3[j], a3[i], acc[i][j]);
    __builtin_amdgcn_sched_barrier(0);
    __builtin_amdgcn_s_barrier();
    __builtin_amdgcn_sched_barrier(0);
    cur = cur == 4 * STG ? 0 : cur + 2 * STG;
    nxt = nxt == 4 * STG ? 0 : nxt + 2 * STG;
  }
  if (grp == 0) __builtin_amdgcn_s_barrier();
#undef DMA3
#pragma unroll
  for (int i = 0; i < 2; ++i)
#pragma unroll
    for (int j = 0; j < 2; ++j)
#pragma unroll
      for (int q = 0; q < 4; q += 2) {
        const int m = wm * 64 + i * 32 + l32, n = wn * 64 + j * 32 + 8 * q;
        const uint2 pa = epi(m, n + 4 * hh, acc[i][j][4 * q], acc[i][j][4 * q + 1], acc[i][j][4 * q + 2], acc[i][j][4 * q + 3]);
        const uint2 pb = epi(m, n + 8 + 4 * hh, acc[i][j][4 * q + 4], acc[i][j][4 * q + 5], acc[i][j][4 * q + 6], acc[i][j][4 * q + 7]);
        store_pair16(rowptr(m) + n, pa, pb, hh);
      }
}

template <class AF, class BF, class EF, class RF>
DI void gemm8w_m128(char* smem, int K, AF arow, BF brow, EF epi, RF rowptr) {
  constexpr int STG = 16384;
  const int tid = tidf_(), lane = tid & 63, wave = tid >> 6;
  const int grp = __builtin_amdgcn_readfirstlane(wave >> 2);
  const int wm = wave >> 1, wn = wave & 1, l32 = lane & 31, hh = lane >> 5;
  const int lr = lane >> 2, lc = ((lane & 3) ^ ((lane >> 4) & 3)) * 8;
  const f16* ap0 = arow(wave * 16 + lr) + lc;
  const f16* bp0 = brow(wave * 16 + lr) + lc;
  const int dA = wave * 1024 + lane * 16, dB = 8192 + wave * 1024 + lane * 16;
#define DMA3(stage_off, ko)                                                                                              \
  __builtin_amdgcn_global_load_lds((const void*)(ap0 + (ko)), (LAS void*)(smem + (stage_off) + dA), 16, 0, 0);          \
  __builtin_amdgcn_global_load_lds((const void*)(bp0 + (ko)), (LAS void*)(smem + (stage_off) + dB), 16, 0, 0);
  const int nk = K >> 5;
  DMA3(0, 0)
  DMA3(STG, 32)
  DMA3(2 * STG, 64)
  DMA3(3 * STG, 96)
  asm volatile("s_waitcnt vmcnt(4)" ::: "memory");
  __builtin_amdgcn_s_barrier();
  if (grp == 1) __builtin_amdgcn_s_barrier();
  f32x16 acc[1][2];
#pragma unroll
  for (int i = 0; i < 1; ++i)
#pragma unroll
    for (int j = 0; j < 2; ++j)
#pragma unroll
      for (int e = 0; e < 16; ++e) acc[i][j][e] = 0.f;
  const int rsw = (l32 >> 2) & 3;
  const int aoff = (wm * 32 + l32) * 64, boff = 8192 + (wn * 64 + l32) * 64;
  const int co0 = ((0 + hh) ^ rsw) << 4, co1 = ((2 + hh) ^ rsw) << 4;
  int cur = 0, nxt = 4 * STG;
  for (int kt = 0; kt < nk; kt += 2) {
    if (kt + 4 < nk) { DMA3(nxt, (kt + 4) * 32) DMA3(nxt + STG, (kt + 5) * 32) }
    const char* st = smem + cur;
    f16x8 a0[1], b0[2], a1[1], b1[2], a2[1], b2[2], a3[1], b3[2];
#pragma unroll
    for (int j = 0; j < 2; ++j) { b0[j] = *(const f16x8*)(st + boff + j * 2048 + co0); b1[j] = *(const f16x8*)(st + boff + j * 2048 + co1); }
#pragma unroll
    for (int i = 0; i < 1; ++i) { a0[i] = *(const f16x8*)(st + aoff + i * 2048 + co0); a1[i] = *(const f16x8*)(st + aoff + i * 2048 + co1); }
#pragma unroll
    for (int j = 0; j < 2; ++j) { b2[j] = *(const f16x8*)(st + STG + boff + j * 2048 + co0); b3[j] = *(const f16x8*)(st + STG + boff + j * 2048 + co1); }
#pragma unroll
    for (int i = 0; i < 1; ++i) { a2[i] = *(const f16x8*)(st + STG + aoff + i * 2048 + co0); a3[i] = *(const f16x8*)(st + STG + aoff + i * 2048 + co1); }
    __builtin_amdgcn_sched_barrier(0);
    if (kt + 4 < nk) asm volatile("s_waitcnt vmcnt(4) lgkmcnt(0)" ::: "memory");
    else asm volatile("s_waitcnt vmcnt(0) lgkmcnt(0)" ::: "memory");
    __builtin_amdgcn_s_barrier();
    __builtin_amdgcn_sched_barrier(0);
#pragma unroll
    for (int i = 0; i < 1; ++i)
#pragma unroll
      for (int j = 0; j < 2; ++j) acc[i][j] = MFMA(b0[j], a0[i], acc[i][j]);
#pragma unroll
    for (int i = 0; i < 1; ++i)
#pragma unroll
      for (int j = 0; j < 2; ++j) acc[i][j] = MFMA(b1[j], a1[i], acc[i][j]);
#pragma unroll
    for (int i = 0; i < 1; ++i)
#pragma unroll
      for (int j = 0; j < 2; ++j) acc[i][j] = MFMA(b2[j], a2[i], acc[i][j]);
#pragma unroll
    for (int i = 0; i < 1; ++i)
#pragma unroll
      for (int j = 0; j < 2; ++j) acc[i][j] = MFMA(b3[j], a3[i], acc[i][j]);
    __builtin_amdgcn_sched_barrier(0);
    __builtin_amdgcn_s_barrier();
    __builtin_amdgcn_sched_barrier(0);
    cur = cur == 4 * STG ? 0 : cur + 2 * STG;
    nxt = nxt == 4 * STG ? 0 : nxt + 2 * STG;
  }
  if (grp == 0) __builtin_amdgcn_s_barrier();
#undef DMA3
#pragma unroll
  for (int i = 0; i < 1; ++i)
#pragma unroll
    for (int j = 0; j < 2; ++j)
#pragma unroll
      for (int q = 0; q < 4; q += 2) {
        const int m = wm * 32 + i * 32 + l32, n = wn * 64 + j * 32 + 8 * q;
        const uint2 pa = epi(m, n + 4 * hh, acc[i][j][4 * q], acc[i][j][4 * q + 1], acc[i][j][4 * q + 2], acc[i][j][4 * q + 3]);
        const uint2 pb = epi(m, n + 8 + 4 * hh, acc[i][j][4 * q + 4], acc[i][j][4 * q + 5], acc[i][j][4 * q + 6], acc[i][j][4 * q + 7]);
        store_pair16(rowptr(m) + n, pa, pb, hh);
      }
}

DI uint2 pack4h(float a, float b, float c, float d) {
  f16x4 v;
  v[0] = (f16)a; v[1] = (f16)b; v[2] = (f16)c; v[3] = (f16)d;
  return __builtin_bit_cast(uint2, v);
}
DI void store_pair16(f16* dst, uint2 a, uint2 b, int hh) {
  const auto r0 = __builtin_amdgcn_permlane32_swap(a.x, b.x, false, false);
  const auto r1 = __builtin_amdgcn_permlane32_swap(a.y, b.y, false, false);
  uint4 o; o.x = r0[0]; o.y = r1[0]; o.z = r0[1]; o.w = r1[1];
  *(uint4*)(dst + 8 * hh) = o;
}
DI void store4h(f16* dst, float a, float b, float c, float d) {
  f16x4 v;
  v[0] = (f16)a; v[1] = (f16)b; v[2] = (f16)c; v[3] = (f16)d;
  *(f16x4*)dst = v;
}

DI void tconv_tile(char* smem, const float* src, int lds, f16* dst, int ldd, int k0, int n0) {
  float* t = (float*)smem;
  const int tid = tid_();
#pragma unroll
  for (int j = 0; j < 4; ++j) {
    const int r = (tid >> 4) + 16 * j, c4 = (tid & 15) * 4;
    const float4 v = *(const float4*)(src + (size_t)(k0 + r) * lds + n0 + c4);
    t[r * 65 + c4] = v.x; t[r * 65 + c4 + 1] = v.y; t[r * 65 + c4 + 2] = v.z; t[r * 65 + c4 + 3] = v.w;
  }
  __syncthreads();
  const int n = tid >> 2, kc = (tid & 3) * 16;
  f16x8 o0, o1;
#pragma unroll
  for (int i = 0; i < 8; ++i) { o0[i] = (f16)t[(kc + i) * 65 + n]; o1[i] = (f16)t[(kc + 8 + i) * 65 + n]; }
  f16* d = dst + (size_t)(n0 + n) * ldd + k0 + kc;
  *(f16x8*)d = o0;
  *(f16x8*)(d + 8) = o1;
  __syncthreads();
}

DI void ada_item(KP P, char* smem, int item) {
  const int tid = tid_(), lane = tid & 63, wave = tid >> 6;
  const int layer = item / 96, rem = item % 96, cb = rem >> 2, kc = rem & 3;
  float* sc = (float*)smem;
  float* red = (float*)smem + 1280;
  for (int i = tid; i < 1280; i += 256) {
    const int j = i >> 8, k = kc * 256 + (i & 255);
    const float v = j == 0 ? P->c_ctx[k] : P->c[(j - 1) * 1024 + k];
    sc[i] = v / (1.f + __expf(-v));
  }
  __syncthreads();
  float a[5][4];
#pragma unroll
  for (int j = 0; j < 5; ++j)
#pragma unroll
    for (int e = 0; e < 4; ++e) a[j][e] = 0.f;
  const float* w = P->ada_w + ((size_t)layer * 1024 + kc * 256 + wave * 64) * 6144 + cb * 256 + lane * 4;
#pragma unroll 8
  for (int i = 0; i < 64; ++i) {
    const float4 v = *(const float4*)(w + (size_t)i * 6144);
#pragma unroll
    for (int j = 0; j < 5; ++j) {
      const float s = sc[j * 256 + wave * 64 + i];
      a[j][0] += s * v.x; a[j][1] += s * v.y; a[j][2] += s * v.z; a[j][3] += s * v.w;
    }
  }
#pragma unroll
  for (int j = 0; j < 5; ++j)
#pragma unroll
    for (int e = 0; e < 4; ++e) red[(wave * 5 + j) * 256 + lane * 4 + e] = a[j][e];
  __syncthreads();
  float* adap = (float*)(P->ws + WS_ADAP);
#pragma unroll
  for (int j = 0; j < 5; ++j) {
    const float s = red[(0 * 5 + j) * 256 + tid] + red[(1 * 5 + j) * 256 + tid] + red[(2 * 5 + j) * 256 + tid] +
                    red[(3 * 5 + j) * 256 + tid];
    adap[((layer * 4 + kc) * 5 + j) * 6144 + cb * 256 + tid] = s;
  }
  __syncthreads();
}

DI void const_item(KP P, int item) {
  f16* fc = (f16*)(P->ws + WS_FC);
  f16* d256 = (f16*)(P->ws + WS_D256);
  f16* f64 = (f16*)(P->ws + WS_F64);
  f16* ds = (f16*)(P->ws + WS_DS);
#pragma unroll 1
  for (int j = 0; j < 8; ++j) {
    int e = item * 2048 + j * 256 + tid_();
    float sn, cs;
    if (e < 32768) {
      const int m = e >> 7, c = e & 127, l = m >> 1, ri = m & 1;
      sincospif((float)((l * c) & 127) * (1.f / 64.f), &sn, &cs);
      fc[e] = (f16)((ri ? -sn : cs) * 0.08838834764831845f);
    } else if (e < 32768 + 131072) {
      e -= 32768;
      const int k = e >> 9, col = e & 511, ri = col >> 8, s = col & 255;
      sincospif((float)((k * s) & 255) * (1.f / 128.f), &sn, &cs);
      d256[e] = (f16)((ri ? sn : cs) * 0.0625f);
    } else if (e < 32768 + 131072 + 16384) {
      e -= 32768 + 131072;
      const int n = e >> 7, col = e & 127, rip = n >> 6, k2 = n & 63, ri = col >> 6, s2 = col & 63;
      sincospif((float)((k2 * s2) & 63) * (1.f / 32.f), &sn, &cs);
      f64[e] = (f16)((rip == ri ? cs : (rip == 0 ? sn : -sn)) * 0.125f);
    } else {
      e -= 32768 + 131072 + 16384;
      const int k = e >> 7, col = e & 127, ri = col >> 6, s1 = col & 63;
      sincospif((float)((k * s1) & 4095) * (1.f / 2048.f), &sn, &cs);
      ds[e] = (f16)((ri ? sn : cs) * 0.125f);
    }
  }
}

DI void phase_prep(KP P, char* smem) {
  constexpr int NADA = 192, NTC = 5792, NCONST = 344;
  smem += half_() * kHalfLds;
  for (int it = blockIdx.x * 2 + half_(); it < NADA + NTC + NCONST; it += gridDim.x * 2) {
    if (it < NADA) {
      ada_item(P, smem, it);
    } else if (it < NADA + NTC) {
      int i = it - NADA;
      const float* src; f16* dst; int K, N;
      if (i < 384) { src = P->e_w_in; dst = (f16*)(P->ws + WS_WIN); K = 1024; N = 1536; }
      else if (i < 640) { i -= 384; src = P->e_w_out; dst = (f16*)(P->ws + WS_WOUT0); K = 1024; N = 1024; }
      else if (i < 2688) { i -= 640; const int l = i >> 10; i &= 1023; src = P->w1 + (size_t)l * 1024 * 4096; dst = (f16*)(P->ws + WS_W1) + (size_t)l * 4096 * 1024; K = 1024; N = 4096; }
      else if (i < 4736) { i -= 2688; const int l = i >> 10; i &= 1023; src = P->w2 + (size_t)l * 4096 * 1024; dst = (f16*)(P->ws + WS_W2) + (size_t)l * 1024 * 4096; K = 4096; N = 1024; }
      else if (i < 5504) { i -= 4736; src = P->o_w_qkv; dst = (f16*)(P->ws + WS_WQKV); K = 1024; N = 3072; }
      else if (i < 5760) { i -= 5504; src = P->o_w_out; dst = (f16*)(P->ws + WS_WO1); K = 1024; N = 1024; }
      else {
        i -= 5760;
        const int hb = i & 7, ri = (i >> 3) & 1, d = i >> 4;
        src = (ri ? P->e_w_i : P->e_w_r) + (size_t)(d * 8 + hb) * 4096;
        dst = (f16*)(P->ws + WS_GW) + (size_t)i * 4096;
        K = 64; N = 64; i = 0;
      }
      const int ntn = N >> 6;
      tconv_tile(smem, src, N, dst, K, (i / ntn) * 64, (i % ntn) * 64);
    } else {
      const_item(P, it - NADA - NTC);
    }
  }
}

#define DPP_ADD(v, ctrl) ((v) + __builtin_bit_cast(float, __builtin_amdgcn_update_dpp(0, __builtin_bit_cast(int, (v)), (ctrl), 0xF, 0xF, true)))
DI float wave_allsum_dpp(float v) {
  v = DPP_ADD(v, 0xB1);
  v = DPP_ADD(v, 0x4E);
  v = DPP_ADD(v, 0x141);
  v = DPP_ADD(v, 0x140);
  const unsigned u = __builtin_bit_cast(unsigned, v);
  const auto r16 = __builtin_amdgcn_permlane16_swap(u, u, false, false);
  v = __builtin_bit_cast(float, (unsigned)r16[0]) + __builtin_bit_cast(float, (unsigned)r16[1]);
  const unsigned w = __builtin_bit_cast(unsigned, v);
  const auto r32 = __builtin_amdgcn_permlane32_swap(w, w, false, false);
  return __builtin_bit_cast(float, (unsigned)r32[0]) + __builtin_bit_cast(float, (unsigned)r32[1]);
}
constexpr int LNB = 5;
DI void wave_sum_n(float (&s)[LNB]) {
#pragma unroll
  for (int o = 32; o; o >>= 1)
#pragma unroll
    for (int r = 0; r < LNB; ++r) s[r] += __shfl_xor(s[r], o);
}
DI void ln_stats(float (&v)[LNB][16], float (&rstd)[LNB]) {
  float s[LNB], s2[LNB];
#pragma unroll
  for (int r = 0; r < LNB; ++r) {
    s[r] = 0.f; s2[r] = 0.f;
#pragma unroll
    for (int k = 0; k < 16; ++k) { s[r] += v[r][k]; s2[r] = fmaf(v[r][k], v[r][k], s2[r]); }
  }
#pragma unroll
  for (int r = 0; r < LNB; ++r) { s[r] = wave_allsum_dpp(s[r]); s2[r] = wave_allsum_dpp(s2[r]); }
#pragma unroll
  for (int r = 0; r < LNB; ++r) {
    const float mean = s[r] * (1.f / 1024.f);
    const float var = fmaxf(s2[r] * (1.f / 1024.f) - mean * mean, 0.f);
    rstd[r] = rsqrtf(var + 1e-5f);
#pragma unroll
    for (int k = 0; k < 16; ++k) v[r][k] -= mean;
  }
}

template <bool SRC_INPUT, bool HAS_LN, bool HAS_MOD, bool DST_OUT>
DI void phase_ln(KP P, const float* g_, const float* b_, int layer, int shift_idx, int scale_idx) {
  const int tid = tidf_(), lane = tid & 63, wave = tid >> 6;
  if (SRC_INPUT) {
    const int e = blockIdx.x * 512 + tid;
    if (e < 2 * 5 * 6144) {
      const int layer_ = e / 30720, rem = e % 30720;
      ((float*)(P->ws + WS_ADAF))[e] = ada_val(P, layer_, rem / 6144, rem % 6144);
    }
  }
  f16* xr = (f16*)(P->ws + WS_XR);
  f16* hbuf = (f16*)(P->ws + WS_H);
  const int nw = gridDim.x * 8, rpw = (T + nw - 1) / nw;
  const int r_begin = (blockIdx.x * 8 + wave) * rpw, r_end = min(T, r_begin + rpw);
  float g[16], bb[16], sc[16], sh[16];
#pragma unroll
  for (int k = 0; k < 16; ++k) {
    const int col = (k >> 2) * 256 + lane * 4 + (k & 3);
    if (HAS_LN) { g[k] = g_[col]; bb[k] = b_[col]; } else { g[k] = 1.f; bb[k] = 0.f; }
    sc[k] = 1.f; sh[k] = 0.f;
  }
  int cur = -1;
#pragma unroll 1
  for (int t = r_begin; t < r_end; t += LNB) {
    float v[LNB][16], rstd[LNB];
#pragma unroll
    for (int r = 0; r < LNB; ++r) {
      const int tt = min(t + r, r_end - 1);
      if (SRC_INPUT) {
        const float* src = tt < TP ? P->x_prompt + (size_t)tt * 1024 : P->x_sample + (size_t)(tt - TP) * 1024;
#pragma unroll
        for (int j = 0; j < 4; ++j) {
          const float4 q = *(const float4*)(src + j * 256 + lane * 4);
          v[r][j * 4] = q.x; v[r][j * 4 + 1] = q.y; v[r][j * 4 + 2] = q.z; v[r][j * 4 + 3] = q.w;
        }
      } else {
#pragma unroll
        for (int j = 0; j < 4; ++j) {
          const f16x4 q = *(const f16x4*)(xr + (size_t)tt * 1024 + j * 256 + lane * 4);
          v[r][j * 4] = (float)q[0]; v[r][j * 4 + 1] = (float)q[1]; v[r][j * 4 + 2] = (float)q[2]; v[r][j * 4 + 3] = (float)q[3];
        }
      }
    }
    ln_stats(v, rstd);
    if (HAS_LN) {
#pragma unroll
      for (int r = 0; r < LNB; ++r) {
#pragma unroll
        for (int k = 0; k < 16; ++k) v[r][k] = v[r][k] * rstd[r] * g[k] + bb[k];
        if (t + r < r_end) {
          if (DST_OUT) {
            float* dst = P->out + (size_t)(t + r) * 1024;
#pragma unroll
            for (int j = 0; j < 4; ++j) {
              float4 q; q.x = v[r][j * 4]; q.y = v[r][j * 4 + 1]; q.z = v[r][j * 4 + 2]; q.w = v[r][j * 4 + 3];
              *(float4*)(dst + j * 256 + lane * 4) = q;
            }
          } else {
#pragma unroll
            for (int j = 0; j < 4; ++j)
              store4h(xr + (size_t)(t + r) * 1024 + j * 256 + lane * 4, v[r][j * 4], v[r][j * 4 + 1], v[r][j * 4 + 2], v[r][j * 4 + 3]);
          }
        }
      }
      if (HAS_MOD) ln_stats(v, rstd);
    }
    if (HAS_MOD) {
#pragma unroll
      for (int r = 0; r < LNB; ++r) {
        if (t + r < r_end) {
          const int cond = cond_of(t + r);
          if (cond != cur) {
            cur = cond;
#pragma unroll
            for (int k = 0; k < 16; ++k) {
              const int col = (k >> 2) * 256 + lane * 4 + (k & 3);
              sh[k] = SRC_INPUT ? ada_val(P, layer, cond, shift_idx * 1024 + col) : adaf(P, layer, cond, shift_idx * 1024 + col);
              sc[k] = 1.f + (SRC_INPUT ? ada_val(P, layer, cond, scale_idx * 1024 + col) : adaf(P, layer, cond, scale_idx * 1024 + col));
            }
          }
          f16* hd = hbuf + (size_t)(t + r) * 1024;
#pragma unroll
          for (int j = 0; j < 4; ++j)
            store4h(hd + j * 256 + lane * 4, v[r][j * 4] * rstd[r] * sc[j * 4] + sh[j * 4], v[r][j * 4 + 1] * rstd[r] * sc[j * 4 + 1] + sh[j * 4 + 1],
                    v[r][j * 4 + 2] * rstd[r] * sc[j * 4 + 2] + sh[j * 4 + 2], v[r][j * 4 + 3] * rstd[r] * sc[j * 4 + 3] + sh[j * 4 + 3]);
        }
      }
    }
  }
}

DI void scan_item(KP P, char* smem, int item, int mode) {
  const int tid = tid_(), lane = tid & 63, wave = tid >> 6, l32 = lane & 31, hh = lane >> 5;
  const int c = item >> 3, hb = item & 7;
  const int t0 = c * 64;
  const bool ctx = c < 64;
  const int bstart = ctx ? (c >> 2) * 256 : TP + ((c - 64) >> 6) * 4096;
  const int bend = bstart + (ctx ? 256 : 4096);
  const f16* u = (const f16*)(P->ws + WS_B1);
  float2* sum = (float2*)(P->ws + WS_SUM);
  float hcarry = 0.f;
  if (mode == 1) {
    const int cfirst = ctx ? (c & ~3) : 64 + ((c - 64) & ~63);
    const int clast = ctx ? (c | 3) : 64 + ((c - 64) | 63);
    const int nf = c - cfirst, nb = clast - c;
    float2* car = (float2*)smem;
    for (int idx = tid; idx < (nf + nb) * 64; idx += 256) {
      const int q = idx >> 6, nn = idx & 63;
      car[idx] = q < nf ? sum[(size_t)((cfirst + q) * 2) * 512 + hb * 64 + nn]
                        : sum[(size_t)((clast - (q - nf)) * 2 + 1) * 512 + hb * 64 + nn];
    }
    __syncthreads();
    if (tid < 128) {
      const int dd = tid >> 6, nn = tid & 63;
      const int lb = ctx ? 0 : ((c - 64) >> 6);
      float h = ctx ? 0.f : P->state_lru[(lb * 2 + dd) * 512 + hb * 64 + nn];
      const int q0 = dd ? nf : 0, q1 = dd ? nf + nb : nf;
#pragma unroll 4
      for (int q = q0; q < q1; ++q) { const float2 sv = car[q * 64 + nn]; h = sv.x * h + sv.y; }
      hcarry = h;
    }
    __syncthreads();
  }
  {
    const int tok = tid >> 2, cb = (tid & 3) * 16, t = t0 + tok, ch0 = hb * 64 + cb;
    float acc[16];
#pragma unroll
    for (int i = 0; i < 4; ++i) {
      const float4 q = *(const float4*)(P->e_conv_b + ch0 + 4 * i);
      acc[4 * i] = q.x; acc[4 * i + 1] = q.y; acc[4 * i + 2] = q.z; acc[4 * i + 3] = q.w;
    }
#pragma unroll
    for (int k = 0; k < 4; ++k) {
      const int tt = t + k - 2;
      if (tt >= bstart && tt < bend) {
        const f16x8 x0 = *(const f16x8*)(u + (size_t)tt * 1536 + ch0);
        const f16x8 x1 = *(const f16x8*)(u + (size_t)tt * 1536 + ch0 + 8);
        float xv[16];
#pragma unroll
        for (int i = 0; i < 8; ++i) { xv[i] = (float)x0[i]; xv[8 + i] = (float)x1[i]; }
#pragma unroll
        for (int i = 0; i < 4; ++i) {
          const float4 wq = *(const float4*)(P->e_conv_w + k * 512 + ch0 + 4 * i);
          acc[4 * i] += wq.x * xv[4 * i]; acc[4 * i + 1] += wq.y * xv[4 * i + 1];
          acc[4 * i + 2] += wq.z * xv[4 * i + 2]; acc[4 * i + 3] += wq.w * xv[4 * i + 3];
        }
      }
    }
    f16x8 o0, o1;
#pragma unroll
    for (int i = 0; i < 8; ++i) { o0[i] = (f16)acc[i]; o1[i] = (f16)acc[8 + i]; }
    *(f16x8*)(smem + tok * 144 + cb * 2) = o0;
    *(f16x8*)(smem + tok * 144 + cb * 2 + 16) = o1;
  }
  {
    const f16* gw = (const f16*)(P->ws + WS_GW);
#pragma unroll
    for (int i = 0; i < 8; ++i) {
      const int id = tid + 256 * i, mat = id >> 9, rem = id & 511, n = rem >> 3, ch = rem & 7;
      const uint4 v = *(const uint4*)(gw + (size_t)(mat * 8 + hb) * 4096 + n * 64 + ch * 8);
      *(uint4*)(smem + 9216 + mat * 9216 + n * 144 + ch * 16) = v;
    }
  }
  __syncthreads();
  const int d = wave >> 1, nh = wave & 1;
  const int n = nh * 32 + l32, ch = hb * 64 + n;
  f32x16 accr0, accr1, acci0, acci1;
#pragma unroll
  for (int i = 0; i < 16; ++i) { accr0[i] = 0.f; accr1[i] = 0.f; acci0[i] = 0.f; acci1[i] = 0.f; }
#pragma unroll
  for (int ks = 0; ks < 4; ++ks) {
    const int ko = (ks * 16 + hh * 8) * 2;
    const f16x8 a0 = *(const f16x8*)(smem + l32 * 144 + ko);
    const f16x8 a1 = *(const f16x8*)(smem + (32 + l32) * 144 + ko);
    const f16x8 br = *(const f16x8*)(smem + 9216 + (d * 2) * 9216 + n * 144 + ko);
    const f16x8 bi = *(const f16x8*)(smem + 9216 + (d * 2 + 1) * 9216 + n * 144 + ko);
    accr0 = MFMA(a0, br, accr0);
    accr1 = MFMA(a1, br, accr1);
    acci0 = MFMA(a0, bi, acci0);
    acci1 = MFMA(a1, bi, acci1);
  }
  float xcv0[16], xcv1[16];
#pragma unroll
  for (int r = 0; r < 16; ++r) {
    xcv0[r] = (float)*(const f16*)(smem + crow(r, hh) * 144 + n * 2);
    xcv1[r] = (float)*(const f16*)(smem + (32 + crow(r, hh)) * 144 + n * 2);
  }
  __syncthreads();
  {
    const float brv = P->e_b_r[d * 512 + ch], biv = P->e_b_i[d * 512 + ch];
    const float sp = log1pf(__expf(-P->e_lam[d * 512 + ch]));
    float* as = (float*)smem + d * 4096;
    float* bs = (float*)smem + 8192 + d * 4096;
#pragma unroll
    for (int r = 0; r < 16; ++r) {
      {
        const int tok = crow(r, hh);
        const float rr = sigmoidf_(accr0[r] + brv), ii = sigmoidf_(acci0[r] + biv);
        const float la = -8.f * rr * sp;
        const float av = __expf(la);
        as[tok * 64 + n] = av;
        bs[tok * 64 + n] = __builtin_amdgcn_sqrtf(fmaxf(fmaf(-av, av, 1.f), 0.f)) * ii * xcv0[r];
      }
      {
        const int tok = 32 + crow(r, hh);
        const float rr = sigmoidf_(accr1[r] + brv), ii = sigmoidf_(acci1[r] + biv);
        const float la = -8.f * rr * sp;
        const float av = __expf(la);
        as[tok * 64 + n] = av;
        bs[tok * 64 + n] = __builtin_amdgcn_sqrtf(fmaxf(fmaf(-av, av, 1.f), 0.f)) * ii * xcv1[r];
      }
    }
  }
  __syncthreads();
  if (tid < 128) {
    const int dd = tid >> 6, nn = tid & 63, cc_ = hb * 64 + nn;
    const float* as = (const float*)smem + dd * 4096 + nn;
    float* bs = (float*)smem + 8192 + dd * 4096 + nn;
    float h = hcarry, p = 1.f;
#pragma unroll 1
    for (int blk = 0; blk < 8; ++blk) {
      const int tb = dd ? 56 - blk * 8 : blk * 8;
      float av[8], bv[8];
#pragma unroll
      for (int i = 0; i < 8; ++i) { av[i] = as[(tb + i) * 64]; bv[i] = bs[(tb + i) * 64]; }
      if (dd == 0) {
#pragma unroll
        for (int i = 0; i < 8; ++i) { h = av[i] * h + bv[i]; p *= av[i]; bv[i] = h; }
      } else {
#pragma unroll
        for (int i = 7; i >= 0; --i) { h = av[i] * h + bv[i]; p *= av[i]; bv[i] = h; }
      }
      if (mode == 1) {
#pragma unroll
        for (int i = 0; i < 8; ++i) bs[(tb + i) * 64] = bv[i];
      }
    }
    if (mode == 0) {
      sum[(size_t)(c * 2 + dd) * 512 + cc_] = make_float2(p, h);
    } else if (ctx) {
      if (dd == 0 && (c & 3) == 3) P->out[OUT_LRU + ((c >> 2) * 2 + 0) * 512 + cc_] = h;
      if (dd == 1 && (c & 3) == 0) P->out[OUT_LRU + ((c >> 2) * 2 + 1) * 512 + cc_] = h;
    }
  }
  __syncthreads();
  if (mode == 1) {
    const int tok = tid >> 2, cb = (tid & 3) * 16, t = t0 + tok;
    const float* hf = (const float*)smem + 8192 + tok * 64 + cb;
    const float* hbw = hf + 4096;
    const f16x8 g0 = *(const f16x8*)(u + (size_t)t * 1536 + 512 + hb * 64 + cb);
    const f16x8 g1 = *(const f16x8*)(u + (size_t)t * 1536 + 512 + hb * 64 + cb + 8);
    f16x8 o0, o1;
#pragma unroll
    for (int i = 0; i < 8; ++i) {
      float x = (float)g0[i];
      float gl = x * sigmoidf_(1.5957691216057308f * (x + 0.044715f * x * x * x));
      o0[i] = (f16)((hf[i] + hbw[i]) * gl);
      x = (float)g1[i];
      gl = x * sigmoidf_(1.5957691216057308f * (x + 0.044715f * x * x * x));
      o1[i] = (f16)((hf[8 + i] + hbw[8 + i]) * gl);
    }
    f16* yc = (f16*)(P->ws + WS_H) + (size_t)t * 1024 + hb * 64 + cb;
    *(f16x8*)yc = o0;
    *(f16x8*)(yc + 8) = o1;
    __syncthreads();
  }
}

template <int MODE>
DI void attn_tile(const char* kb_, const char* vb_, const char* bt, const int (&bi0)[16], const int (&bi1)[16], const f16x8 q0,
                  const f16x8 q1, const f16x8 q2, const f16x8 q3, float& m, float& lsum, f32x16& o0, f32x16& o1, int l32, int hh, int rsw) {
#define LIVE0(r) (MODE != 2 || (r) >= 12)
#define LIVE1(r) (MODE != 1 || (r) < 4)
  f32x16 s0, s1;
#pragma unroll
  for (int i = 0; i < 16; ++i) { s0[i] = 0.f; s1[i] = 0.f; }
  {
    int co = ((0 + hh) ^ rsw) << 4;
    s0 = MFMA(*(const f16x8*)(kb_ + l32 * 128 + co), q0, s0);
    s1 = MFMA(*(const f16x8*)(kb_ + (32 + l32) * 128 + co), q0, s1);
    co = ((2 + hh) ^ rsw) << 4;
    s0 = MFMA(*(const f16x8*)(kb_ + l32 * 128 + co), q1, s0);
    s1 = MFMA(*(const f16x8*)(kb_ + (32 + l32) * 128 + co), q1, s1);
    co = ((4 + hh) ^ rsw) << 4;
    s0 = MFMA(*(const f16x8*)(kb_ + l32 * 128 + co), q2, s0);
    s1 = MFMA(*(const f16x8*)(kb_ + (32 + l32) * 128 + co), q2, s1);
    co = ((6 + hh) ^ rsw) << 4;
    s0 = MFMA(*(const f16x8*)(kb_ + l32 * 128 + co), q3, s0);
    s1 = MFMA(*(const f16x8*)(kb_ + (32 + l32) * 128 + co), q3, s1);
  }
  if (MODE != 0) {
#pragma unroll
    for (int r = 0; r < 16; ++r) {
      if (LIVE0(r)) s0[r] += *(const float*)(bt + bi0[r]);
      if (LIVE1(r)) s1[r] += *(const float*)(bt + bi1[r]);
    }
  }
  float mx = -INFINITY;
#pragma unroll
  for (int r = 0; r < 16; ++r) {
    if (LIVE0(r)) mx = fmaxf(mx, s0[r]);
    if (LIVE1(r)) mx = fmaxf(mx, s1[r]);
  }
  {
    const unsigned mu = __builtin_bit_cast(unsigned, mx);
    const auto mr = __builtin_amdgcn_permlane32_swap(mu, mu, false, false);
    mx = fmaxf(__builtin_bit_cast(float, (unsigned)mr[0]), __builtin_bit_cast(float, (unsigned)mr[1]));
  }
  const float mn = fmaxf(m, mx);
  const float alpha = __builtin_amdgcn_exp2f(m - mn);
  m = mn;
  float ps0 = 0.f, ps1 = 0.f;
#pragma unroll
  for (int r = 0; r < 16; ++r) {
    if (LIVE0(r)) { s0[r] = __builtin_amdgcn_exp2f(s0[r] - mn); ps0 += s0[r]; } else s0[r] = 0.f;
    if (LIVE1(r)) { s1[r] = __builtin_amdgcn_exp2f(s1[r] - mn); ps1 += s1[r]; } else s1[r] = 0.f;
  }
  lsum = lsum * alpha + (ps0 + ps1);
  if (__any(alpha != 1.f)) {
#pragma unroll
    for (int r = 0; r < 16; ++r) { o0[r] *= alpha; o1[r] *= alpha; }
  }
#pragma unroll
  for (int kb = 0; kb < 2; ++kb)
#pragma unroll
    for (int st = 0; st < 2; ++st) {
      if ((MODE == 1 && kb == 1 && st == 1) || (MODE == 2 && kb == 0 && st == 0)) continue;
      typedef __attribute__((ext_vector_type(2))) __fp16 h2_t;
      typedef __attribute__((ext_vector_type(4))) unsigned u4_t;
      u4_t pu;
#pragma unroll
      for (int e = 0; e < 4; ++e) {
        const h2_t hv = kb == 0 ? __builtin_amdgcn_cvt_pkrtz(s0[8 * st + 2 * e], s0[8 * st + 2 * e + 1])
                                : __builtin_amdgcn_cvt_pkrtz(s1[8 * st + 2 * e], s1[8 * st + 2 * e + 1]);
        pu[e] = __builtin_bit_cast(unsigned, hv);
      }
      const f16x8 pf = __builtin_bit_cast(f16x8, pu);
      const int c0 = ((4 * kb + 2 * st) ^ rsw) << 4, c1 = ((4 * kb + 2 * st + 1) ^ rsw) << 4;
      {
        const f16x4 lo = *(const f16x4*)(vb_ + l32 * 128 + c0 + 8 * hh);
        const f16x4 hi = *(const f16x4*)(vb_ + l32 * 128 + c1 + 8 * hh);
        const f16x8 va = __builtin_shufflevector(lo, hi, 0, 1, 2, 3, 4, 5, 6, 7);
        o0 = MFMA(va, pf, o0);
      }
      {
        const f16x4 lo = *(const f16x4*)(vb_ + (32 + l32) * 128 + c0 + 8 * hh);
        const f16x4 hi = *(const f16x4*)(vb_ + (32 + l32) * 128 + c1 + 8 * hh);
        const f16x8 va = __builtin_shufflevector(lo, hi, 0, 1, 2, 3, 4, 5, 6, 7);
        o1 = MFMA(va, pf, o1);
      }
    }
#undef LIVE0
#undef LIVE1
}

DI void attn_item(KP P, char* smem, int item) {
  constexpr int NS = 6, PD = 4;
  const int tid = tidf_(), lane = tid & 63, wave = tid >> 6, l32 = lane & 31, hh = lane >> 5;
  const int sub = wave >> 1, sw = wave & 1;
  float* rpbs = (float*)(smem + NS * 16384);
  const bool latent = item < 1024;
  const int sid = (latent ? item : item - 1024) * 4 + sub;
  const f16* qbuf = (const f16*)(P->ws + WS_B1);
  const f16* kbuf = qbuf + (size_t)T * 1024;
  const char* b2 = (const char*)P->out;
  int b, h, row = 0, rs = 0, qtok0, ntiles, nloc = 0, a0 = 0;
  if (latent) {
    b = sid >> 10; h = (sid >> 6) & 15; row = sid & 63; rs = min(max(row - 4, 0), 56); qtok0 = TP + b * 4096 + row * 64;
    const int r0 = row & ~3;
    a0 = min(max(r0 - 4, 0), 56);
    const int a1 = min(max(r0 - 1, 0), 56) + 7;
    nloc = a1 - a0 + 1; ntiles = nloc + 8;
  } else { b = sid >> 6; h = (sid >> 2) & 15; qtok0 = b * 256 + (sid & 3) * 64; ntiles = 4; }
  const int drow = wave * 8 + (lane >> 3), dch = ((lane & 7) ^ ((drow >> 1) & 7)) * 8;
  const int dlds = wave * 1024 + lane * 16;
  auto dma = [&](int j) {
    const f16 *kp, *vp; size_t kst, vst;
    if (latent) {
      if (j < nloc) {
        kp = kbuf + (size_t)(TP + b * 4096 + (a0 + j) * 64) * 1024 + h * 64; kst = 1024;
        vp = (const f16*)(b2 + B2_VTL) + (size_t)((b * 16 + h) * 64) * 4096 + (a0 + j) * 64; vst = 4096;
      } else {
        kp = (const f16*)(b2 + B2_CK) + (size_t)((b * 16 + h) * 512 + (j - nloc) * 64) * 64; kst = 64;
        vp = (const f16*)(b2 + B2_CVT) + (size_t)((b * 16 + h) * 64) * 512 + (j - nloc) * 64; vst = 512;
      }
    } else {
      kp = kbuf + (size_t)(b * 256 + j * 64) * 1024 + h * 64; kst = 1024;
      vp = (const f16*)(b2 + B2_VTC) + (size_t)((b * 16 + h) * 64) * 256 + j * 64; vst = 256;
    }
    char* st = smem + (j % NS) * 16384;
    __builtin_amdgcn_global_load_lds((const void*)(kp + (size_t)drow * kst + dch), (LAS void*)(st + dlds), 16, 0, 0);
    __builtin_amdgcn_global_load_lds((const void*)(vp + (size_t)drow * vst + dch), (LAS void*)(st + 8192 + dlds), 16, 0, 0);
  };
#pragma unroll
  for (int j = 0; j < PD; ++j) if (j < ntiles) dma(j);
  if (latent) for (int i = tid; i < 480; i += 512) { const int rr = i >> 5, cc = i & 31; rpbs[i] = cc < 31 ? P->o_rpb[h * 465 + rr * 31 + cc] * LOG2E : -INFINITY; }
  const int qc = sw * 32 + l32;
  const f16* qp = qbuf + (size_t)(qtok0 + qc) * 1024 + h * 64 + hh * 8;
  const f16x8 q0 = *(const f16x8*)qp, q1 = *(const f16x8*)(qp + 16), q2 = *(const f16x8*)(qp + 32), q3 = *(const f16x8*)(qp + 48);
  __syncthreads();
  float m = -INFINITY, lsum = 0.f;
  f32x16 o0, o1;
#pragma unroll
  for (int i = 0; i < 16; ++i) { o0[i] = 0.f; o1[i] = 0.f; }
  const int rsw = (l32 >> 1) & 7;
  const int cs = min(max(qc - 8, 0), 48);
  int bi0[16], bi1[16];
#pragma unroll
  for (int r = 0; r < 16; ++r) {
    const int k0 = crow(r, hh), k1 = 32 + k0;
    bi0[r] = ((k0 >= cs && k0 < cs + 16) ? (k0 - qc + 15) : 31) * 4;
    bi1[r] = ((k1 >= cs && k1 < cs + 16) ? (k1 - qc + 15) : 31) * 4;
  }
#pragma unroll 1
  for (int j = 0; j < ntiles; ++j) {
    if (j + PD < ntiles) dma(j + PD);
    {
      const int ahead = min(PD, ntiles - 1 - j);
      if (ahead >= 4) asm volatile("s_waitcnt vmcnt(8)" ::: "memory");
      else if (ahead == 3) asm volatile("s_waitcnt vmcnt(6)" ::: "memory");
      else if (ahead == 2) asm volatile("s_waitcnt vmcnt(4)" ::: "memory");
      else if (ahead == 1) asm volatile("s_waitcnt vmcnt(2)" ::: "memory");
      else asm volatile("s_waitcnt vmcnt(0)" ::: "memory");
    }
    __builtin_amdgcn_s_barrier();
    __builtin_amdgcn_sched_barrier(0);
    const char* kb_ = smem + (j % NS) * 16384;
    const char* vb_ = kb_ + 8192;
    const bool act = !latent || j >= nloc || (a0 + j >= rs && a0 + j <= rs + 7);
    if (act) {
      if (latent && j < nloc) {
        const char* bt = (const char*)rpbs + (a0 + j - row + 7) * 128;
        if (sw == 0) attn_tile<1>(kb_, vb_, bt, bi0, bi1, q0, q1, q2, q3, m, lsum, o0, o1, l32, hh, rsw);
        else attn_tile<2>(kb_, vb_, bt, bi0, bi1, q0, q1, q2, q3, m, lsum, o0, o1, l32, hh, rsw);
      } else {
        attn_tile<0>(kb_, vb_, nullptr, bi0, bi1, q0, q1, q2, q3, m, lsum, o0, o1, l32, hh, rsw);
      }
    }
  }
  __syncthreads();
  float inv;
  {
    const unsigned lu = __builtin_bit_cast(unsigned, lsum);
    const auto lr_ = __builtin_amdgcn_permlane32_swap(lu, lu, false, false);
    inv = 1.f / (__builtin_bit_cast(float, (unsigned)lr_[0]) + __builtin_bit_cast(float, (unsigned)lr_[1]));
  }
  f16* op = (f16*)(P->ws + WS_H) + (size_t)(qtok0 + qc) * 1024 + h * 64;
#pragma unroll
  for (int q = 0; q < 4; ++q) {
    store4h(op + 8 * q + 4 * hh, o0[4 * q] * inv, o0[4 * q + 1] * inv, o0[4 * q + 2] * inv, o0[4 * q + 3] * inv);
    store4h(op + 32 + 8 * q + 4 * hh, o1[4 * q] * inv, o1[4 * q + 1] * inv, o1[4 * q + 2] * inv, o1[4 * q + 3] * inv);
  }
}

struct TileIter {
  int lt, step, nt, x;
  DI TileIter(int NT) {
    nt = NT;
    if (gridDim.x == 256) { x = blockIdx.x & 7; lt = blockIdx.x >> 3; step = 32; }
    else { x = -1; lt = blockIdx.x; step = gridDim.x; }
  }
  DI bool valid() const { return lt < (x >= 0 ? 10 * nt : 80 * nt); }
  DI int tm() const { return x >= 0 ? x + 8 * (lt / nt) : lt / nt; }
  DI int tn() const { return lt % nt; }
  DI void next() { lt += step; }
};

DI void phase_gin(KP P, char* smem) {
  const f16* hb = (const f16*)(P->ws + WS_H);
  const f16* w = (const f16*)(P->ws + WS_WIN);
  f16* u = (f16*)(P->ws + WS_B1);
  for (TileIter ti(6); ti.valid(); ti.next()) {
    const int tm = ti.tm(), tn = ti.tn();
    gemm8w<256, true, true>(smem, 1024, [&](int r) { return hb + (size_t)(tm * 256 + r) * 1024; },
              [&](int r) { return w + (size_t)(tn * 256 + r) * 1024; },
              [&](int m, int n, float v0, float v1, float v2, float v3) {
                const float4 bias = *(const float4*)(P->e_b_in + tn * 256 + n);
                return pack4h(v0 + bias.x, v1 + bias.y, v2 + bias.z, v3 + bias.w);
              }, [&](int m) { return u + (size_t)(tm * 256 + m) * 1536 + tn * 256; });
  }
}

DI void g1_tile(KP P, char* smem, int tile) {
  const int g = tile & 3, nt = (tile >> 2) & 1, mt = tile >> 3;
  const f16* u = (const f16*)(P->ws + WS_B1);
  const f16* fc = (const f16*)(P->ws + WS_FC);
  char* b2 = (char*)P->out;
  gemm_tile<true>(smem, 128,
            [&](int r) {
              const int m = mt * 256 + r;
              int tok = m;
              if (m >= TP) { const int lm = m - TP; tok = TP + (lm & ~4095) + ((lm >> 6) & 63) + 64 * (lm & 63); }
              return u + (size_t)tok * 1536 + 1024 + g * 128;
            },
            [&](int r) { return fc + (size_t)(nt * 128 + r) * 128; },
            [&](int m_, int n_, float v0, float v1, float v2, float v3) {
              const int m = mt * 256 + m_, n = nt * 128 + n_, l = n >> 1;
              f16* d;
              size_t ls, rs_;
              if (m < TP) {
                const int b = m >> 8, s_ = m & 255;
                d = (f16*)(b2 + B2_W1C) + ((size_t)((b * 4 + g) * 128 + l) * 512 + s_); ls = 512; rs_ = 256;
              } else {
                const int lm = m - TP, b = lm >> 12, s1 = (lm >> 6) & 63, s2 = lm & 63;
                d = (f16*)(b2 + B2_W1L) + ((size_t)(((b * 4 + g) * 128 + l) * 64 + s1) * 128 + s2); ls = 64 * 128; rs_ = 64;
              }
              d[0] = (f16)v0; d[rs_] = (f16)v1; d[ls] = (f16)v2; d[ls + rs_] = (f16)v3;
            });
}

DI void ct1_tile(KP P, char* smem, int mt) {
  char* b2 = (char*)P->out;
  const f16* w1l = (const f16*)(b2 + B2_W1L);
  const f16* f64 = (const f16*)(P->ws + WS_F64);
  f16* z = (f16*)(b2 + B2_Z);
  gemm_tile<true>(smem, 128, [&](int r) { return w1l + (size_t)(mt * 256 + r) * 128; }, [&](int r) { return f64 + (size_t)r * 128; },
            [&](int m_, int n, float v0, float v1, float v2, float v3) {
              const int m = mt * 256 + m_, bgl = m >> 6, s1 = m & 63, rip = n >> 6, k2 = n & 63;
              f16* d = z + ((size_t)(k2 * 2048 + bgl) * 128 + rip * 64 + s1);
              constexpr size_t ks = 2048ull * 128;
              d[0] = (f16)v0; d[ks] = (f16)v1; d[2 * ks] = (f16)v2; d[3 * ks] = (f16)v3;
            });
}

DI void ctxdft_tile(KP P, char* smem, int tile) {
  const int nt = tile & 1, mt = tile >> 1;
  char* b2 = (char*)P->out;
  const f16* w1c = (const f16*)(b2 + B2_W1C);
  const f16* dm = (const f16*)(P->ws + WS_D256);
  f16* yc = (f16*)(P->ws + WS_H);
  gemm_tile<true>(smem, 512, [&](int r) { return w1c + (size_t)(mt * 256 + r) * 512; },
            [&](int r) { return dm + (size_t)(nt * 128 + r) * 512; },
            [&](int m_, int n_, float v0, float v1, float v2, float v3) {
              const int m = mt * 256 + m_, k = nt * 128 + n_, b = m >> 9, g = (m >> 7) & 3, l = m & 127;
              f16* d = yc + (size_t)(b * 256 + k) * 1024 + 512 + g * 128 + l;
              d[0] = (f16)v0; d[1024] = (f16)v1; d[2048] = (f16)v2; d[3072] = (f16)v3;
            });
}

DI void ct2_tile(KP P, char* smem, int tile) {
  const int k2 = tile >> 3, mt = tile & 7;
  char* b2 = (char*)P->out;
  const f16* z = (const f16*)(b2 + B2_Z);
  const f16* dsm = (const f16*)(P->ws + WS_DS);
  f16* yc = (f16*)(P->ws + WS_H);
  gemm_tile<true>(smem, 128, [&](int r) { return z + (size_t)(k2 * 2048 + mt * 256 + r) * 128; },
            [&](int r) { return dsm + (size_t)(64 * (r & 63) + k2) * 128; },
            [&](int m_, int n, float v0, float v1, float v2, float v3) {
              if (n < 64) {
                const int m = mt * 256 + m_, b = m >> 9, g = (m >> 7) & 3, l = m & 127, k = 64 * n + k2;
                f16* d = yc + (size_t)(TP + b * 4096 + k) * 1024 + 512 + g * 128 + l;
                constexpr size_t ks = 64ull * 1024;
                d[0] = (f16)v0; d[ks] = (f16)v1; d[2 * ks] = (f16)v2; d[3 * ks] = (f16)v3;
              }
            });
}

template <bool FROM_INPUT>
DI void phase_proj(KP P, char* smem, const f16* w, const float* bias_, int layer, int gate_idx) {
  const f16* a = (const f16*)(P->ws + WS_H);
  f16* xr = (f16*)(P->ws + WS_XR);
  auto epi_at = [&](int t, int col, float v0, float v1, float v2, float v3) {
    const int cond = cond_of(t);
    const float4 bias = *(const float4*)(bias_ + col);
    const float4 gt = *(const float4*)((const float*)(P->ws + WS_ADAF) + (layer * 5 + cond) * 6144 + gate_idx * 1024 + col);
    float4 x;
    if (FROM_INPUT) {
      x = *(const float4*)((t < TP ? P->x_prompt + (size_t)t * 1024 : P->x_sample + (size_t)(t - TP) * 1024) + col);
    } else {
      const f16x4 q = *(const f16x4*)(xr + (size_t)t * 1024 + col);
      x.x = (float)q[0]; x.y = (float)q[1]; x.z = (float)q[2]; x.w = (float)q[3];
    }
    return pack4h(ALPHA * x.x + gt.x * (v0 + bias.x), ALPHA * x.y + gt.y * (v1 + bias.y),
                  ALPHA * x.z + gt.z * (v2 + bias.z), ALPHA * x.w + gt.w * (v3 + bias.w));
  };
  auto full_tile = [&](int tm, int tn) {
    gemm8w_n128(smem, 1024, [&](int r) { return a + (size_t)(tm * 256 + r) * 1024; },
                [&](int r) { return w + (size_t)(tn * 128 + r) * 1024; },
                [&](int m, int n, float v0, float v1, float v2, float v3) { return epi_at(tm * 256 + m, tn * 128 + n, v0, v1, v2, v3); },
                [&](int m) { return xr + (size_t)(tm * 256 + m) * 1024 + tn * 128; });
  };
  if (gridDim.x == 256) {
    const int x = blockIdx.x & 7, li = blockIdx.x >> 3;
    for (int lt = li; lt < 64; lt += 32) full_tile(x + 8 * (lt >> 3), lt & 7);
    const int tm = x + 8 * (8 + (li >> 4)), tn = (li & 15) >> 1, r0 = tm * 256 + (li & 1) * 128;
    gemm8w_m128(smem, 1024, [&](int r) { return a + (size_t)(r0 + r) * 1024; }, [&](int r) { return w + (size_t)(tn * 128 + r) * 1024; },
                [&](int m, int n, float v0, float v1, float v2, float v3) { return epi_at(r0 + m, tn * 128 + n, v0, v1, v2, v3); },
                [&](int m) { return xr + (size_t)(r0 + m) * 1024 + tn * 128; });
  } else {
    for (TileIter ti(8); ti.valid(); ti.next()) full_tile(ti.tm(), ti.tn());
  }
}

DI void phase_mlp1(KP P, char* smem, int layer) {
  const f16* a = (const f16*)(P->ws + WS_H);
  const f16* w = (const f16*)(P->ws + WS_W1) + (size_t)layer * 4096 * 1024;
  const float* bias_ = P->b1 + layer * 4096;
  for (TileIter ti(16); ti.valid(); ti.next()) {
    const int tm = ti.tm(), tn = ti.tn();
    f16* hid = tm * 256 < TH ? (f16*)P->out + (size_t)(tm * 256) * 4096 : (f16*)(P->ws + WS_B1) + (size_t)(tm * 256 - TH) * 4096;
    gemm8w<256, true, true>(smem, 1024, [&](int r) { return a + (size_t)(tm * 256 + r) * 1024; },
              [&](int r) { return w + (size_t)(tn * 256 + r) * 1024; },
              [&](int m, int n, float v0, float v1, float v2, float v3) {
                const float4 bias = *(const float4*)(bias_ + tn * 256 + n);
                v0 = fmaxf(v0 + bias.x, 0.f); v1 = fmaxf(v1 + bias.y, 0.f); v2 = fmaxf(v2 + bias.z, 0.f); v3 = fmaxf(v3 + bias.w, 0.f);
                return pack4h(v0 * v0, v1 * v1, v2 * v2, v3 * v3);
              }, [&](int m) { return hid + (size_t)m * 4096 + tn * 256; });
  }
}

DI void phase_mlp2(KP P, char* smem, int layer) {
  const f16* w = (const f16*)(P->ws + WS_W2) + (size_t)layer * 1024 * 4096;
  const float* bias_ = P->b2 + layer * 1024;
  f16* xr = (f16*)(P->ws + WS_XR);
  auto epi_at = [&](int t, int col, float v0, float v1, float v2, float v3) {
    const int cond = cond_of(t);
    const float4 bias = *(const float4*)(bias_ + col);
    const float4 gt = *(const float4*)((const float*)(P->ws + WS_ADAF) + (layer * 5 + cond) * 6144 + 5 * 1024 + col);
    f16* d = xr + (size_t)t * 1024 + col;
    const f16x4 q = *(const f16x4*)d;
    return pack4h(ALPHA * (float)q[0] + gt.x * (v0 + bias.x), ALPHA * (float)q[1] + gt.y * (v1 + bias.y),
                  ALPHA * (float)q[2] + gt.z * (v2 + bias.z), ALPHA * (float)q[3] + gt.w * (v3 + bias.w));
  };
  auto hid_row = [&](int t) { return t < TH ? (const f16*)P->out + (size_t)t * 4096 : (const f16*)(P->ws + WS_B1) + (size_t)(t - TH) * 4096; };
  auto full_tile = [&](int tm, int tn) {
    const f16* hid = hid_row(tm * 256);
    gemm8w_n128(smem, 4096, [&](int r) { return hid + (size_t)r * 4096; }, [&](int r) { return w + (size_t)(tn * 128 + r) * 4096; },
                [&](int m, int n, float v0, float v1, float v2, float v3) { return epi_at(tm * 256 + m, tn * 128 + n, v0, v1, v2, v3); },
                [&](int m) { return xr + (size_t)(tm * 256 + m) * 1024 + tn * 128; });
  };
  if (gridDim.x == 256) {
    const int x = blockIdx.x & 7, li = blockIdx.x >> 3;
    for (int lt = li; lt < 64; lt += 32) full_tile(x + 8 * (lt >> 3), lt & 7);
    const int tm = x + 8 * (8 + (li >> 4)), tn = (li & 15) >> 1, r0 = tm * 256 + (li & 1) * 128;
    const f16* hid = hid_row(r0);
    gemm8w_m128(smem, 4096, [&](int r) { return hid + (size_t)r * 4096; }, [&](int r) { return w + (size_t)(tn * 128 + r) * 4096; },
                [&](int m, int n, float v0, float v1, float v2, float v3) { return epi_at(r0 + m, tn * 128 + n, v0, v1, v2, v3); },
                [&](int m) { return xr + (size_t)(r0 + m) * 1024 + tn * 128; });
  } else {
    for (TileIter ti(8); ti.valid(); ti.next()) full_tile(ti.tm(), ti.tn());
  }
}

DI void qkv_tile(KP P, char* smem, int tile) {
  const int tm = tile / 12, tn = tile % 12;
  const f16* a = (const f16*)(P->ws + WS_H);
  const f16* w = (const f16*)(P->ws + WS_WQKV);
  f16* qbuf = (f16*)(P->ws + WS_B1);
  f16* kbuf = qbuf + (size_t)T * 1024;
  char* b2 = (char*)P->out;
  if (tn < 8) {
    gemm8w<256, true, true>(smem, 1024, [&](int r) { return a + (size_t)(tm * 256 + r) * 1024; },
              [&](int r) { return w + (size_t)(tn * 256 + r) * 1024; },
              [&](int m, int n, float v0, float v1, float v2, float v3) {
                const int col = tn * 256 + n, t = tm * 256 + m;
                const float4 bias = *(const float4*)(P->o_b_qkv + col);
                v0 += bias.x; v1 += bias.y; v2 += bias.z; v3 += bias.w;
                if (col < 1024) return pack4h(v0 * QSCALE, v1 * QSCALE, v2 * QSCALE, v3 * QSCALE);
                const int cc = col - 1024;
                if (t < TP) {
                  const int b = t >> 8, s = t & 255, hd = cc >> 6, dd = cc & 63;
                  float4 o; o.x = v0; o.y = v1; o.z = v2; o.w = v3;
                  *(float4*)(P->out + OUT_NK + ((size_t)((b * 16 + hd) * 256 + s) * 64 + dd)) = o;
                }
                return pack4h(v0, v1, v2, v3);
              }, [&](int m) { return (tn < 4 ? qbuf + tn * 256 : kbuf + (tn - 4) * 256) + (size_t)(tm * 256 + m) * 1024; });
  } else {
    gemm8w<256, false>(smem, 1024, [&](int r) { return a + (size_t)(tm * 256 + r) * 1024; },
              [&](int r) { return w + (size_t)(tn * 256 + r) * 1024; },
              [&](int m, int n, float v0, float v1, float v2, float v3) {
                const int col = tn * 256 + n, t = tm * 256 + m;
                const float bias = P->o_b_qkv[col];
                v0 += bias; v1 += bias; v2 += bias; v3 += bias;
                const int cc = col - 2048, hd = cc >> 6, dd = cc & 63;
                if (t < TP) {
                  const int b = t >> 8, s = t & 255;
                  store4h((f16*)(b2 + B2_VTC) + ((size_t)((b * 16 + hd) * 64 + dd) * 256 + s), v0, v1, v2, v3);
                  float* o = P->out + OUT_NV + ((size_t)((b * 16 + hd) * 256 + s) * 64 + dd);
                  o[0] = v0; o[64] = v1; o[128] = v2; o[192] = v3;
                } else {
                  const int lt = t - TP, b = lt >> 12, s = lt & 4095;
                  store4h((f16*)(b2 + B2_VTL) + ((size_t)((b * 16 + hd) * 64 + dd) * 4096 + s), v0, v1, v2, v3);
                }
              });
  }
}

DI void phase_qkv(KP P, char* smem) {
  constexpr int NG = 80 * 12, NCK = 256, NCV = 512;
  char* b2 = (char*)P->out;
  for (TileIter ti(12); ti.valid(); ti.next()) qkv_tile(P, smem, ti.tm() * 12 + ti.tn());
  char* hsm = smem + half_() * kHalfLds;
  int it0 = blockIdx.x * 2 + half_(), itstep = gridDim.x * 2;
  if (gridDim.x == 256) {
    const int li = blockIdx.x >> 3;
    if (li >= 24) { it0 = (((li - 24) * 8 + (blockIdx.x & 7)) * 2) + half_(); itstep = 128; } else { it0 = NCK + NCV; }
  }
  for (int it = it0; it < NCK + NCV; it += itstep) {
    if (it < NCK) {
      const int i0 = it * 8192;
      f16* ck = (f16*)(b2 + B2_CK);
#pragma unroll
      for (int j = 0; j < 8; ++j) {
        const int e = i0 + (j * 256 + tid_()) * 4;
        const float4 v = *(const float4*)(P->cache_k + e);
        store4h(ck + e, v.x, v.y, v.z, v.w);
      }
    } else {
      const int i = it - NCK, bh = i >> 3, kt = i & 7;
      tconv_tile(hsm, P->cache_v + (size_t)bh * 512 * 64, 64, (f16*)(b2 + B2_CVT) + (size_t)bh * 64 * 512, 512, kt * 64, 0);
    }
  }
}

#define XB_TMO      128
#define XB_XCNT(j)  (256  + 64 * (j))
#define XB_XSUB(j)  (1280 + 64 * (j))
#define XB_XGEN(j)  (2304 + 64 * (j))
#define XB_TOP      3328
#define XB_TOPGEN   3392
#define XCD_BAR_WORDS 3456
#define XB_SPIN_CAP (1u << 18)
DI unsigned xb_ld(unsigned* p) { return __hip_atomic_load(p, __ATOMIC_RELAXED, __HIP_MEMORY_SCOPE_AGENT); }
DI unsigned xb_add(unsigned* p, unsigned v) { return __hip_atomic_fetch_add(p, v, __ATOMIC_RELAXED, __HIP_MEMORY_SCOPE_AGENT); }
DI unsigned xb_xcc_id() { return (unsigned)__builtin_amdgcn_s_getreg((3 << 11) | 20) & 0xFu; }
#define XB_SPIN(cond, bar) do { unsigned _sp = 0; while (cond) { __builtin_amdgcn_s_sleep(1); \
    if ((++_sp & 255u) == 0u) { if (xb_ld(&(bar)[XB_TMO])) break; if (_sp > XB_SPIN_CAP) { atomicAdd(&(bar)[XB_TMO], 1u); break; } } } } while (0)
struct XcdBarrier { unsigned* bar; unsigned x; volatile LAS unsigned* st; };
DI XcdBarrier xcd_barrier_post(unsigned* bar, volatile LAS unsigned* st) {
  XcdBarrier b; b.bar = bar; b.x = xb_xcc_id(); b.st = st;
  if (threadIdx.x == 0) (void)xb_add(&bar[XB_XCNT(b.x)], 1u);
  return b;
}
DI void xcd_barrier_complete(unsigned* bar, unsigned x, unsigned& nloc, unsigned& nx) {
  const unsigned G = gridDim.x * gridDim.y * gridDim.z;
  unsigned sum, cnt, mine, sp = 0u;
  for (;;) {
    sum = 0u; cnt = 0u; mine = 0u;
#pragma unroll
    for (unsigned j = 0; j < 16; ++j) { const unsigned c = xb_ld(&bar[XB_XCNT(j)]); sum += c; cnt += (c > 0u) ? 1u : 0u; mine = (j == x) ? c : mine; }
    if (sum == G) break;
    __builtin_amdgcn_s_sleep(1);
    if ((++sp & 255u) == 0u) { if (xb_ld(&bar[XB_TMO])) break; if (sp > XB_SPIN_CAP) { atomicAdd(&bar[XB_TMO], 1u); break; } }
  }
  nloc = mine > 0u ? mine : 1u; nx = cnt > 0u ? cnt : 1u;
}
DI void xcd_barrier(const XcdBarrier& b) {
  asm volatile("s_waitcnt vmcnt(0)" ::: "memory");
  __syncthreads();
  if (threadIdx.x == 0) {
    unsigned* bar = b.bar;
    __builtin_amdgcn_s_waitcnt(0);
    unsigned nloc = b.st[0], nx = b.st[1];
    if (nloc == 0u) { xcd_barrier_complete(bar, b.x, nloc, nx); b.st[0] = nloc; b.st[1] = nx; }
    const unsigned old = xb_add(&bar[XB_XSUB(b.x)], 1u);
    const unsigned gen = old / nloc;
    if (old + 1u == (gen + 1u) * nloc) {
      __builtin_amdgcn_fence(__ATOMIC_RELEASE, "agent");
      asm volatile("s_waitcnt vmcnt(0)" ::: "memory");
      const unsigned og = xb_add(&bar[XB_TOP], 1u);
      const unsigned tg = og / nx;
      if (og + 1u == (tg + 1u) * nx) xb_add(&bar[XB_TOPGEN], 1u);
      else XB_SPIN(xb_ld(&bar[XB_TOPGEN]) == tg, bar);
      __builtin_amdgcn_fence(__ATOMIC_ACQUIRE, "agent");
      xb_add(&bar[XB_XGEN(b.x)], 1u);
      asm volatile("s_waitcnt vmcnt(0)" ::: "memory");
    } else {
      XB_SPIN(xb_ld(&bar[XB_XGEN(b.x)]) == gen, bar);
      __builtin_amdgcn_fence(__ATOMIC_ACQUIRE, "agent");
      asm volatile("s_waitcnt vmcnt(0)" ::: "memory");
    }
  }
  __syncthreads();
}

enum { PH_PREP = 0, PH_LN0, PH_GIN, PH_SCAN0, PH_SCAN1, PH_CT2, PH_OUT0, PH_LN1, PH_MLP1A, PH_MLP2A, PH_LN2, PH_QKV, PH_ATT,
       PH_OUT1, PH_LN3, PH_MLP1B, PH_MLP2B, PH_LN4, NPH };

__global__ void __launch_bounds__(512, 2) mk(Params PP) {
  extern __shared__ __attribute__((aligned(16))) char smem[];
  cg::grid_group grid = cg::this_grid();
  __shared__ uint4 xb_words;
  if (threadIdx.x == 0) xb_words = make_uint4(0u, 0u, 0u, 0u);
  __syncthreads();
  const XcdBarrier xb = xcd_barrier_post((unsigned*)(PP.ws + WS_BAR), (volatile LAS unsigned*)&xb_words);
  const int phase_hi = PP.phase_hi;
  if (phase_hi > 1000) grid.sync();
  for (int ph = PP.phase_lo; ph < phase_hi; ++ph) {
   const int reps = (ph == REP_PHASE) ? 2 : 1;
   for (int rep = 0; rep < reps; ++rep) {
    KP P = (KP)__builtin_amdgcn_kernarg_segment_ptr();
    asm volatile("" : "+s"(P));
    switch (ph) {
      case PH_PREP: phase_prep(P, smem); break;
      case PH_LN0: phase_ln<true, false, true, false>(P, nullptr, nullptr, 0, 0, 1); break;
      case PH_GIN: phase_gin(P, smem); break;
      case PH_SCAN0:
        for (int it = blockIdx.x * 2 + half_(); it < 2560 + 640; it += gridDim.x * 2) {
          char* hsm = smem + half_() * kHalfLds;
          if (it < 2560) scan_item(P, hsm, it, 0); else g1_tile(P, hsm, it - 2560);
        }
        break;
      case PH_SCAN1:
        for (int it = blockIdx.x * 2 + half_(); it < 64 + 2560 + 512; it += gridDim.x * 2) {
          char* hsm = smem + half_() * kHalfLds;
          if (it < 64) ctxdft_tile(P, hsm, it);
          else if (it < 64 + 2560) scan_item(P, hsm, it - 64, 1);
          else ct1_tile(P, hsm, it - 64 - 2560);
        }
        break;
      case PH_CT2:
        for (int it = blockIdx.x * 2 + half_(); it < 512; it += gridDim.x * 2) ct2_tile(P, smem + half_() * kHalfLds, it);
        break;
      case PH_OUT0: phase_proj<true>(P, smem, (const f16*)(P->ws + WS_WOUT0), P->e_b_out, 0, 2); break;
      case PH_LN1: phase_ln<false, true, true, false>(P, P->ln1_g, P->ln1_b, 0, 3, 4); break;
      case PH_MLP1A: phase_mlp1(P, smem, 0); break;
      case PH_MLP2A: phase_mlp2(P, smem, 0); break;
      case PH_LN2: phase_ln<false, true, true, false>(P, P->ln2_g, P->ln2_b, 1, 0, 1); break;
      case PH_QKV: phase_qkv(P, smem); break;
      case PH_ATT:
        for (int it = blockIdx.x; it < 1280; it += gridDim.x) {
          int item = it;
          if (it < 1024 && gridDim.x == 256) {
            const int x = blockIdx.x & 7, li = blockIdx.x >> 3, r = it >> 8;
            item = (r * 16 + 2 * x + (li >> 4)) * 16 + (li & 15);
          }
          attn_item(P, smem, item);
        }
        break;
      case PH_OUT1: phase_proj<false>(P, smem, (const f16*)(P->ws + WS_WO1), P->o_b_out, 1, 2); break;
      case PH_LN3: phase_ln<false, true, true, false>(P, P->ln1_g + 1024, P->ln1_b + 1024, 1, 3, 4); break;
      case PH_MLP1B: phase_mlp1(P, smem, 1); break;
      case PH_MLP2B: phase_mlp2(P, smem, 1); break;
      case PH_LN4: phase_ln<false, true, false, true>(P, P->ln2_g + 1024, P->ln2_b + 1024, 1, 0, 0); break;
    }
    if (ph + 1 < phase_hi || rep + 1 < reps) xcd_barrier(xb);
   }
  }
}

extern "C" void kernel_launch(void* const* d_in, const int* in_sizes, int n_in, void* d_out, int out_size, void* d_ws,
                              size_t ws_size, hipStream_t stream) {
  static int grid_blocks = 0;
  if (!grid_blocks) {
    hipFuncSetAttribute((const void*)mk, hipFuncAttributeMaxDynamicSharedMemorySize, kLds);
    int dev = 0, cus = 0, per_cu = 0;
    hipGetDevice(&dev);
    hipDeviceGetAttribute(&cus, hipDeviceAttributeMultiprocessorCount, dev);
    hipOccupancyMaxActiveBlocksPerMultiprocessor(&per_cu, mk, 512, kLds);
    if (per_cu > 1) per_cu = 1;
    grid_blocks = cus * per_cu;
  }
  Params p{};
  const float** pp = (const float**)&p;
  for (int i = 0; i < 33; ++i) pp[i] = (const float*)d_in[i];
  p.out = (float*)d_out;
  p.ws = (char*)d_ws;
  p.phase_lo = 0;
  p.phase_hi = NPH;
  if (ws_size < WS_END) { fprintf(stderr, "workspace too small: %zu < %zu\n", ws_size, (size_t)WS_END); return; }
  hipMemsetAsync((char*)d_ws + WS_BAR, 0, XCD_BAR_WORDS * 4, stream);
  void* args[] = {&p};
  hipError_t e = hipLaunchCooperativeKernel((const void*)mk, dim3(grid_blocks), dim3(512), args, kLds, stream);
  if (e != hipSuccess) fprintf(stderr, "cooperative launch failed: %s (grid %d)\n", hipGetErrorString(e), grid_blocks);
}
```

```cpp
#include <hip/hip_runtime.h>
#include <hip/hip_cooperative_groups.h>
#include <cstdio>
namespace cg = cooperative_groups;

typedef _Float16 f16;
typedef __attribute__((ext_vector_type(8))) _Float16 f16x8;
typedef __attribute__((ext_vector_type(4))) _Float16 f16x4;
typedef __attribute__((ext_vector_type(16))) float f32x16;
#define DI __device__ __forceinline__
#define LAS __attribute__((address_space(3)))
#define MFMA(a, b, c) __builtin_amdgcn_mfma_f32_32x32x16_f16((a), (b), (c), 0, 0, 0)

constexpr int T = 20480;
constexpr int TP = 4096;
constexpr int TH = 10240;
constexpr float ALPHA = 1.41421356237f;
constexpr float LOG2E = 1.4426950408889634f;
constexpr float QSCALE = 0.125f * LOG2E;
constexpr int kLds = 147456;
#define REP_PHASE -1

constexpr size_t WS_WIN = 0;
constexpr size_t WS_WOUT0 = WS_WIN + 1536ull * 1024 * 2;
constexpr size_t WS_W1 = WS_WOUT0 + 1024ull * 1024 * 2;
constexpr size_t WS_W2 = WS_W1 + 2ull * 4096 * 1024 * 2;
constexpr size_t WS_WQKV = WS_W2 + 2ull * 4096 * 1024 * 2;
constexpr size_t WS_WO1 = WS_WQKV + 3072ull * 1024 * 2;
constexpr size_t WS_GW = WS_WO1 + 1024ull * 1024 * 2;
constexpr size_t WS_FC = WS_GW + 32ull * 4096 * 2;
constexpr size_t WS_D256 = WS_FC + 256ull * 128 * 2;
constexpr size_t WS_F64 = WS_D256 + 256ull * 512 * 2;
constexpr size_t WS_DS = WS_F64 + 128ull * 128 * 2;
constexpr size_t WS_ADAP = WS_DS + 4096ull * 128 * 2;
constexpr size_t WS_SUM = WS_ADAP + 2ull * 4 * 5 * 6144 * 4;
constexpr size_t WS_XR = WS_SUM + 320ull * 2 * 512 * 8;
constexpr size_t WS_H = WS_XR + (size_t)T * 1024 * 4;
constexpr size_t WS_B1 = WS_H + (size_t)T * 1024 * 2;
constexpr size_t WS_BAR = WS_B1 + (size_t)T * 1024 * 4;
constexpr size_t WS_ADAF = WS_BAR + 3456 * 4;
constexpr size_t WS_END = WS_ADAF + 2ull * 5 * 6144 * 4;
constexpr size_t B2_W1C = 0;
constexpr size_t B2_W1L = 8388608;
constexpr size_t B2_Z = 41943040;
constexpr size_t B2_VTC = 0;
constexpr size_t B2_VTL = 8388608;
constexpr size_t B2_CK = 41943040;
constexpr size_t B2_CVT = 46137344;
constexpr size_t OUT_LRU = (size_t)T * 1024;
constexpr size_t OUT_NK = OUT_LRU + 16 * 2 * 512;
constexpr size_t OUT_NV = OUT_NK + 16ull * 16 * 256 * 64;

struct Params {
  const float *x_prompt, *x_sample, *c, *state_lru, *cache_k, *cache_v, *c_ctx, *ada_w, *ada_b, *ln1_g, *ln1_b, *ln2_g,
      *ln2_b, *w1, *b1, *w2, *b2, *e_w_in, *e_b_in, *e_conv_w, *e_conv_b, *e_w_r, *e_b_r, *e_w_i, *e_b_i, *e_lam,
      *e_w_out, *e_b_out, *o_w_qkv, *o_b_qkv, *o_rpb, *o_w_out, *o_b_out;
  float* out;
  char* ws;
  int phase_lo, phase_hi;
};

typedef const __attribute__((address_space(4))) Params* KP;
DI int tidf_() { int t = threadIdx.x; asm volatile("" : "+v"(t)); return t; }
DI int tid_() { return tidf_() & 255; }
DI int half_() { return __builtin_amdgcn_readfirstlane((int)(threadIdx.x >> 8)); }
constexpr int kHalfLds = 73728;
DI int crow(int reg, int hh) { return (reg & 3) + 8 * (reg >> 2) + 4 * hh; }
DI float wave_sum(float v) {
#pragma unroll
  for (int o = 32; o; o >>= 1) v += __shfl_xor(v, o);
  return v;
}
DI float sigmoidf_(float x) { return __builtin_amdgcn_rcpf(1.f + __expf(-x)); }
DI float one_minus_exp(float x) {
  const float p = -x * (1.f + x * (0.5f + x * (0.16666667f + x * (0.041666668f + x * (0.0083333338f + x * 0.0013888889f)))));
  return x > -0.25f ? p : 1.f - __expf(x);
}
DI float ada_val(KP P, int layer, int cond, int idx) {
  const float* adap = (const float*)(P->ws + WS_ADAP);
  float s = P->ada_b[layer * 6144 + idx];
#pragma unroll
  for (int kc = 0; kc < 4; ++kc) s += adap[((layer * 4 + kc) * 5 + cond) * 6144 + idx];
  return s;
}
DI float adaf(KP P, int layer, int cond, int idx) { return ((const float*)(P->ws + WS_ADAF))[(layer * 5 + cond) * 6144 + idx]; }
DI int cond_of(int t) { return t < TP ? 0 : 1 + ((t - TP) >> 12); }

template <bool TR = false, int VAR = 0, class AF, class BF, class EF>
DI void gemm_tile(char* smem, int K, AF arow, BF brow, EF epi) {
  const int tid = tid_(), lane = tid & 63, wave = tid >> 6;
  const int wm = wave >> 1, wn = wave & 1, l32 = lane & 31, hh = lane >> 5;
  const int lr = lane >> 2, lc = ((lane & 3) ^ ((lane >> 4) & 3)) * 8;
  const f16* ap0 = arow(wave * 64 + lr) + lc;
  const f16* ap1 = arow(wave * 64 + 16 + lr) + lc;
  const f16* ap2 = arow(wave * 64 + 32 + lr) + lc;
  const f16* ap3 = arow(wave * 64 + 48 + lr) + lc;
  const f16* bp0 = brow(wave * 32 + lr) + lc;
  const f16* bp1 = brow(wave * 32 + 16 + lr) + lc;
  const int dA = wave * 4096 + lane * 16, dB = 16384 + wave * 2048 + lane * 16;
#define DMA(stage_off, ko)                                                                                       \
  __builtin_amdgcn_global_load_lds((const void*)(ap0 + (ko)), (LAS void*)(smem + (stage_off) + dA), 16, 0, 0);          \
  __builtin_amdgcn_global_load_lds((const void*)(ap1 + (ko)), (LAS void*)(smem + (stage_off) + dA + 1024), 16, 0, 0);   \
  __builtin_amdgcn_global_load_lds((const void*)(ap2 + (ko)), (LAS void*)(smem + (stage_off) + dA + 2048), 16, 0, 0);   \
  __builtin_amdgcn_global_load_lds((const void*)(ap3 + (ko)), (LAS void*)(smem + (stage_off) + dA + 3072), 16, 0, 0);   \
  __builtin_amdgcn_global_load_lds((const void*)(bp0 + (ko)), (LAS void*)(smem + (stage_off) + dB), 16, 0, 0);          \
  __builtin_amdgcn_global_load_lds((const void*)(bp1 + (ko)), (LAS void*)(smem + (stage_off) + dB + 1024), 16, 0, 0);
  const int nk = K >> 5;
  DMA(0, 0)
  DMA(24576, 32)
  asm volatile("s_waitcnt vmcnt(6)" ::: "memory");
  __builtin_amdgcn_s_barrier();
  f32x16 acc[4][2];
#pragma unroll
  for (int i = 0; i < 4; ++i)
#pragma unroll
    for (int j = 0; j < 2; ++j)
#pragma unroll
      for (int e = 0; e < 16; ++e) acc[i][j][e] = 0.f;
  const int rsw = (l32 >> 2) & 3;
  const int aoff = (wm * 128 + l32) * 64, boff = 16384 + (wn * 64 + l32) * 64;
  int cur = 0, nxt = 49152;
  for (int kt = 0; kt < nk; ++kt) {
    if (kt + 2 < nk) { const int kk = kt + 2; DMA(nxt, (VAR == 1 ? 0 : VAR == 3 ? ((((kk >> 1) ^ lr) << 6) + (kk & 1) * 32) : kk * 32)) }
    const char* st = smem + cur;
    {
      const int co0 = ((0 + hh) ^ rsw) << 4, co1 = ((2 + hh) ^ rsw) << 4;
      f16x8 a0[4], b0[2], a1[4], b1[2];
#pragma unroll
      for (int j = 0; j < 2; ++j) b0[j] = *(const f16x8*)(st + boff + j * 2048 + co0);
#pragma unroll
      for (int i = 0; i < 4; ++i) a0[i] = *(const f16x8*)(st + aoff + i * 2048 + co0);
#pragma unroll
      for (int j = 0; j < 2; ++j) b1[j] = *(const f16x8*)(st + boff + j * 2048 + co1);
#pragma unroll
      for (int i = 0; i < 4; ++i) a1[i] = *(const f16x8*)(st + aoff + i * 2048 + co1);
      __builtin_amdgcn_sched_barrier(0);
      if (VAR == 2) { acc[0][0][0] += (float)a0[0][0] + (float)b0[0][0] + (float)a1[3][0] + (float)b1[1][0]; } else {
#pragma unroll
      for (int i = 0; i < 4; ++i)
#pragma unroll
        for (int j = 0; j < 2; ++j) acc[i][j] = TR ? MFMA(b0[j], a0[i], acc[i][j]) : MFMA(a0[i], b0[j], acc[i][j]);
#pragma unroll
      for (int i = 0; i < 4; ++i)
#pragma unroll
        for (int j = 0; j < 2; ++j) acc[i][j] = TR ? MFMA(b1[j], a1[i], acc[i][j]) : MFMA(a1[i], b1[j], acc[i][j]);
      }
      __builtin_amdgcn_sched_barrier(0);
    }
    if (kt + 2 < nk) asm volatile("s_waitcnt vmcnt(6)" ::: "memory");
    else asm volatile("s_waitcnt vmcnt(0)" ::: "memory");
    __builtin_amdgcn_s_barrier();
    cur = cur == 49152 ? 0 : cur + 24576;
    nxt = nxt == 49152 ? 0 : nxt + 24576;
  }
#undef DMA
#pragma unroll
  for (int i = 0; i < 4; ++i)
#pragma unroll
    for (int j = 0; j < 2; ++j)
#pragma unroll
      for (int q = 0; q < 4; ++q)
        if (TR) epi(wm * 128 + i * 32 + l32, wn * 64 + j * 32 + 8 * q + 4 * hh, acc[i][j][4 * q], acc[i][j][4 * q + 1], acc[i][j][4 * q + 2], acc[i][j][4 * q + 3]);
        else epi(wm * 128 + i * 32 + 8 * q + 4 * hh, wn * 64 + j * 32 + l32, acc[i][j][4 * q], acc[i][j][4 * q + 1], acc[i][j][4 * q + 2], acc[i][j][4 * q + 3]);
}

template <int BN, bool TR, bool PK = false, class AF, class BF, class EF, class RF = int>
DI void gemm8w(char* smem, int K, AF arow, BF brow, EF epi, RF rowptr = 0) {
  constexpr int WN = BN / 64, WM = 8 / WN, MI = 256 / (WM * 32), NB = BN / 128;
  constexpr int STG = 16384 + BN * 64;
  const int tid = tidf_(), lane = tid & 63, wave = tid >> 6;
  const int grp = __builtin_amdgcn_readfirstlane(wave >> 2);
  const int wm = wave / WN, wn = wave % WN, l32 = lane & 31, hh = lane >> 5;
  const int lr = lane >> 2, lc = ((lane & 3) ^ ((lane >> 4) & 3)) * 8;
  const f16* ap0 = arow(wave * 32 + lr) + lc;
  const f16* ap1 = arow(wave * 32 + 16 + lr) + lc;
  const f16* bp0 = brow(wave * (16 * NB) + lr) + lc;
  const f16* bp1 = NB == 2 ? brow(wave * 32 + 16 + lr) + lc : bp0;
  const int dA = wave * 2048 + lane * 16, dB = 16384 + wave * (1024 * NB) + lane * 16;
#define DMA4(stage_off, ko)                                                                                              \
  __builtin_amdgcn_global_load_lds((const void*)(ap0 + (ko)), (LAS void*)(smem + (stage_off) + dA), 16, 0, 0);          \
  __builtin_amdgcn_global_load_lds((const void*)(ap1 + (ko)), (LAS void*)(smem + (stage_off) + dA + 1024), 16, 0, 0);   \
  __builtin_amdgcn_global_load_lds((const void*)(bp0 + (ko)), (LAS void*)(smem + (stage_off) + dB), 16, 0, 0);          \
  if (NB == 2) __builtin_amdgcn_global_load_lds((const void*)(bp1 + (ko)), (LAS void*)(smem + (stage_off) + dB + 1024), 16, 0, 0);
  const int nk = K >> 5;
  DMA4(0, 0)
  DMA4(STG, 32)
  DMA4(2 * STG, 64)
  if (NB == 2) asm volatile("s_waitcnt vmcnt(8)" ::: "memory"); else asm volatile("s_waitcnt vmcnt(6)" ::: "memory");
  __builtin_amdgcn_s_barrier();
  if (grp == 1) __builtin_amdgcn_s_barrier();
  f32x16 acc[MI][2];
#pragma unroll
  for (int i = 0; i < MI; ++i)
#pragma unroll
    for (int j = 0; j < 2; ++j)
#pragma unroll
      for (int e = 0; e < 16; ++e) acc[i][j][e] = 0.f;
  const int rsw = (l32 >> 2) & 3;
  const int aoff = (wm * (MI * 32) + l32) * 64, boff = 16384 + (wn * 64 + l32) * 64;
  const int co0 = ((0 + hh) ^ rsw) << 4, co1 = ((2 + hh) ^ rsw) << 4;
  int cur = 0, nxt = 3 * STG;
  for (int kt = 0; kt < nk; ++kt) {
    const char* st = smem + cur;
    f16x8 a0[MI], b0[2], a1[MI], b1[2];
#pragma unroll
    for (int j = 0; j < 2; ++j) b0[j] = *(const f16x8*)(st + boff + j * 2048 + co0);
#pragma unroll
    for (int i = 0; i < MI; ++i) a0[i] = *(const f16x8*)(st + aoff + i * 2048 + co0);
#pragma unroll
    for (int j = 0; j < 2; ++j) b1[j] = *(const f16x8*)(st + boff + j * 2048 + co1);
#pragma unroll
    for (int i = 0; i < MI; ++i) a1[i] = *(const f16x8*)(st + aoff + i * 2048 + co1);
    __builtin_amdgcn_sched_barrier(0);
    if (kt + 3 < nk) { DMA4(nxt, (kt + 3) * 32) }
    __builtin_amdgcn_sched_barrier(0);
    if (kt + 3 < nk) {
      if (NB == 2) asm volatile("s_waitcnt vmcnt(8) lgkmcnt(0)" ::: "memory"); else asm volatile("s_waitcnt vmcnt(6) lgkmcnt(0)" ::: "memory");
    } else {
      asm volatile("s_waitcnt vmcnt(0) lgkmcnt(0)" ::: "memory");
    }
    __builtin_amdgcn_s_barrier();
    __builtin_amdgcn_sched_barrier(0);
#pragma unroll
    for (int i = 0; i < MI; ++i)
#pragma unroll
      for (int j = 0; j < 2; ++j) acc[i][j] = TR ? MFMA(b0[j], a0[i], acc[i][j]) : MFMA(a0[i], b0[j], acc[i][j]);
#pragma unroll
    for (int i = 0; i < MI; ++i)
#pragma unroll
      for (int j = 0; j < 2; ++j) acc[i][j] = TR ? MFMA(b1[j], a1[i], acc[i][j]) : MFMA(a1[i], b1[j], acc[i][j]);
    __builtin_amdgcn_sched_barrier(0);
    __builtin_amdgcn_s_barrier();
    __builtin_amdgcn_sched_barrier(0);
    cur = cur == 3 * STG ? 0 : cur + STG;
    nxt = nxt == 3 * STG ? 0 : nxt + STG;
  }
  if (grp == 0) __builtin_amdgcn_s_barrier();
#undef DMA4
  if constexpr (PK) {
#pragma unroll
    for (int i = 0; i < MI; ++i)
#pragma unroll
      for (int j = 0; j < 2; ++j)
#pragma unroll
        for (int q = 0; q < 4; q += 2) {
          const int m = wm * (MI * 32) + i * 32 + l32, n = wn * 64 + j * 32 + 8 * q;
          const uint2 pa = epi(m, n + 4 * hh, acc[i][j][4 * q], acc[i][j][4 * q + 1], acc[i][j][4 * q + 2], acc[i][j][4 * q + 3]);
          const uint2 pb = epi(m, n + 8 + 4 * hh, acc[i][j][4 * q + 4], acc[i][j][4 * q + 5], acc[i][j][4 * q + 6], acc[i][j][4 * q + 7]);
          store_pair16(rowptr(m) + n, pa, pb, hh);
        }
  } else
#pragma unroll
  for (int i = 0; i < MI; ++i)
#pragma unroll
    for (int j = 0; j < 2; ++j)
#pragma unroll
      for (int q = 0; q < 4; ++q)
        if (TR) epi(wm * (MI * 32) + i * 32 + l32, wn * 64 + j * 32 + 8 * q + 4 * hh, acc[i][j][4 * q], acc[i][j][4 * q + 1], acc[i][j][4 * q + 2], acc[i][j][4 * q + 3]);
        else epi(wm * (MI * 32) + i * 32 + 8 * q + 4 * hh, wn * 64 + j * 32 + l32, acc[i][j][4 * q], acc[i][j][4 * q + 1], acc[i][j][4 * q + 2], acc[i][j][4 * q + 3]);
}

template <class AF, class BF, class EF, class RF>
DI void gemm8w_n128(char* smem, int K, AF arow, BF brow, EF epi, RF rowptr) {
  constexpr int STG = 24576;
  const int tid = tidf_(), lane = tid & 63, wave = tid >> 6;
  const int grp = __builtin_amdgcn_readfirstlane(wave >> 2);
  const int wm = wave >> 1, wn = wave & 1, l32 = lane & 31, hh = lane >> 5;
  const int lr = lane >> 2, lc = ((lane & 3) ^ ((lane >> 4) & 3)) * 8;
  const f16* ap0 = arow(wave * 32 + lr) + lc;
  const f16* ap1 = arow(wave * 32 + 16 + lr) + lc;
  const f16* bp0 = brow(wave * 16 + lr) + lc;
  const int dA = wave * 2048 + lane * 16, dB = 16384 + wave * 1024 + lane * 16;
#define DMA3(stage_off, ko)                                                                                              \
  __builtin_amdgcn_global_load_lds((const void*)(ap0 + (ko)), (LAS void*)(smem + (stage_off) + dA), 16, 0, 0);          \
  __builtin_amdgcn_global_load_lds((const void*)(ap1 + (ko)), (LAS void*)(smem + (stage_off) + dA + 1024), 16, 0, 0);   \
  __builtin_amdgcn_global_load_lds((const void*)(bp0 + (ko)), (LAS void*)(smem + (stage_off) + dB), 16, 0, 0);
  const int nk = K >> 5;
  DMA3(0, 0)
  DMA3(STG, 32)
  DMA3(2 * STG, 64)
  DMA3(3 * STG, 96)
  asm volatile("s_waitcnt vmcnt(6)" ::: "memory");
  __builtin_amdgcn_s_barrier();
  if (grp == 1) __builtin_amdgcn_s_barrier();
  f32x16 acc[2][2];
#pragma unroll
  for (int i = 0; i < 2; ++i)
#pragma unroll
    for (int j = 0; j < 2; ++j)
#pragma unroll
      for (int e = 0; e < 16; ++e) acc[i][j][e] = 0.f;
  const int rsw = (l32 >> 2) & 3;
  const int aoff = (wm * 64 + l32) * 64, boff = 16384 + (wn * 64 + l32) * 64;
  const int co0 = ((0 + hh) ^ rsw) << 4, co1 = ((2 + hh) ^ rsw) << 4;
  int cur = 0, nxt = 4 * STG;
  for (int kt = 0; kt < nk; kt += 2) {
    const char* st = smem + cur;
    f16x8 a0[2], b0[2], a1[2], b1[2], a2[2], b2[2], a3[2], b3[2];
#pragma unroll
    for (int j = 0; j < 2; ++j) { b0[j] = *(const f16x8*)(st + boff + j * 2048 + co0); b1[j] = *(const f16x8*)(st + boff + j * 2048 + co1); }
#pragma unroll
    for (int i = 0; i < 2; ++i) { a0[i] = *(const f16x8*)(st + aoff + i * 2048 + co0); a1[i] = *(const f16x8*)(st + aoff + i * 2048 + co1); }
#pragma unroll
    for (int j = 0; j < 2; ++j) { b2[j] = *(const f16x8*)(st + STG + boff + j * 2048 + co0); b3[j] = *(const f16x8*)(st + STG + boff + j * 2048 + co1); }
#pragma unroll
    for (int i = 0; i < 2; ++i) { a2[i] = *(const f16x8*)(st + STG + aoff + i * 2048 + co0); a3[i] = *(const f16x8*)(st + STG + aoff + i * 2048 + co1); }
    __builtin_amdgcn_sched_barrier(0);
    if (kt + 4 < nk) { DMA3(nxt, (kt + 4) * 32) DMA3(nxt + STG, (kt + 5) * 32) }
    __builtin_amdgcn_sched_barrier(0);
    if (kt + 4 < nk) asm volatile("s_waitcnt vmcnt(6) lgkmcnt(0)" ::: "memory");
    else asm volatile("s_waitcnt vmcnt(0) lgkmcnt(0)" ::: "memory");
    __builtin_amdgcn_s_barrier();
    __builtin_amdgcn_sched_barrier(0);
#pragma unroll
    for (int i = 0; i < 2; ++i)
#pragma unroll
      for (int j = 0; j < 2; ++j) acc[i][j] = MFMA(b0[j], a0[i], acc[i][j]);
#pragma unroll
    for (int i = 0; i < 2; ++i)
#pragma unroll
      for (int j = 0; j < 2; ++j) acc[i][j] = MFMA(b1[j], a1[i], acc[i][j]);
#pragma unroll
    for (int i = 0; i < 2; ++i)
#pragma unroll
      for (int j = 0; j < 2; ++j) acc[i][j] = MFMA(b2[j], a2[i], acc[i][j]);
#pragma unroll
    for (int i = 0; i < 2; ++i)
#pragma unroll
      for (int j = 0; j < 2; ++j) acc[i][j] = MFMA(b3[j], a3[i], acc[i][j]);
    __builtin_amdgcn_sched_barrier(0);
    __builtin_amdgcn_s_barrier();
    __builtin_amdgcn_sched_barrier(0);
    cur = cur == 4 * STG ? 0 : cur + 2 * STG;
    nxt = nxt == 4 * STG ? 0 : nxt + 2 * STG;
  }
  if (grp == 0) __builtin_amdgcn_s_barrier();
#undef DMA3
#pragma unroll
  for (int i = 0; i < 2; ++i)
#pragma unroll
    for (int j = 0; j < 2; ++j)
#pragma unroll
      for (int q = 0; q < 4; q += 2) {
        const int m = wm * 64 + i * 32 + l32, n = wn * 64 + j * 32 + 8 * q;
        const uint2 pa = epi(m, n + 4 * hh, acc[i][j][4 * q], acc[i][j][4 * q + 1], acc[i][j][4 * q + 2], acc[i][j][4 * q + 3]);
        const uint2 pb = epi(m, n + 8 + 4 * hh, acc[i][j][4 * q + 4], acc[i][j][4 * q + 5], acc[i][j][4 * q + 6], acc[i][j][4 * q + 7]);
        store_pair16(rowptr(m) + n, pa, pb, hh);
      }
}

template <class AF, class BF, class EF, class RF>
DI void gemm8w_m128(char* smem, int K, AF arow, BF brow, EF epi, RF rowptr) {
  constexpr int STG = 16384;
  const int tid = tidf_(), lane = tid & 63, wave = tid >> 6;
  const int grp = __builtin_amdgcn_readfirstlane(wave >> 2);
  const int wm = wave >> 1, wn = wave & 1, l32 = lane & 31, hh = lane >> 5;
  const int lr = lane >> 2, lc = ((lane & 3) ^ ((lane >> 4) & 3)) * 8;
  const f16* ap0 = arow(wave * 16 + lr) + lc;
  const f16* bp0 = brow(wave * 16 + lr) + lc;
  const int dA = wave * 1024 + lane * 16, dB = 8192 + wave * 1024 + lane * 16;
#define DMA3(stage_off, ko)                                                                                              \
  __builtin_amdgcn_global_load_lds((const void*)(ap0 + (ko)), (LAS void*)(smem + (stage_off) + dA), 16, 0, 0);          \
  __builtin_amdgcn_global_load_lds((const void*)(bp0 + (ko)), (LAS void*)(smem + (stage_off) + dB), 16, 0, 0);
  const int nk = K >> 5;
  DMA3(0, 0)
  DMA3(STG, 32)
  DMA3(2 * STG, 64)
  DMA3(3 * STG, 96)
  asm volatile("s_waitcnt vmcnt(4)" ::: "memory");
  __builtin_amdgcn_s_barrier();
  if (grp == 1) __builtin_amdgcn_s_barrier();
  f32x16 acc[1][2];
#pragma unroll
  for (int i = 0; i < 1; ++i)
#pragma unroll
    for (int j = 0; j < 2; ++j)
#pragma unroll
      for (int e = 0; e < 16; ++e) acc[i][j][e] = 0.f;
  const int rsw = (l32 >> 2) & 3;
  const int aoff = (wm * 32 + l32) * 64, boff = 8192 + (wn * 64 + l32) * 64;
  const int co0 = ((0 + hh) ^ rsw) << 4, co1 = ((2 + hh) ^ rsw) << 4;
  int cur = 0, nxt = 4 * STG;
  for (int kt = 0; kt < nk; kt += 2) {
    const char* st = smem + cur;
    f16x8 a0[1], b0[2], a1[1], b1[2], a2[1], b2[2], a3[1], b3[2];
#pragma unroll
    for (int j = 0; j < 2; ++j) { b0[j] = *(const f16x8*)(st + boff + j * 2048 + co0); b1[j] = *(const f16x8*)(st + boff + j * 2048 + co1); }
#pragma unroll
    for (int i = 0; i < 1; ++i) { a0[i] = *(const f16x8*)(st + aoff + i * 2048 + co0); a1[i] = *(const f16x8*)(st + aoff + i * 2048 + co1); }
#pragma unroll
    for (int j = 0; j < 2; ++j) { b2[j] = *(const f16x8*)(st + STG + boff + j * 2048 + co0); b3[j] = *(const f16x8*)(st + STG + boff + j * 2048 + co1); }
#pragma unroll
    for (int i = 0; i < 1; ++i) { a2[i] = *(const f16x8*)(st + STG + aoff + i * 2048 + co0); a3[i] = *(const f16x8*)(st + STG + aoff + i * 2048 + co1); }
    __builtin_amdgcn_sched_barrier(0);
    if (kt + 4 < nk) { DMA3(nxt, (kt + 4) * 32) DMA3(nxt + STG, (kt + 5) * 32) }
    __builtin_amdgcn_sched_barrier(0);
    if (kt + 4 < nk) asm volatile("s_waitcnt vmcnt(4) lgkmcnt(0)" ::: "memory");
    else asm volatile("s_waitcnt vmcnt(0) lgkmcnt(0)" ::: "memory");
    __builtin_amdgcn_s_barrier();
    __builtin_amdgcn_sched_barrier(0);
#pragma unroll
    for (int i = 0; i < 1; ++i)
#pragma unroll
      for (int j = 0; j < 2; ++j) acc[i][j] = MFMA(b0[j], a0[i], acc[i][j]);
#pragma unroll
    for (int i = 0; i < 1; ++i)
#pragma unroll
      for (int j = 0; j < 2; ++j) acc[i][j] = MFMA(b1[j], a1[i], acc[i][j]);
#pragma unroll
    for (int i = 0; i < 1; ++i)
#pragma unroll
      for (int j = 0; j < 2; ++j) acc[i][j] = MFMA(b2[j], a2[i], acc[i][j]);
#pragma unroll
    for (int i = 0; i < 1; ++i)
#pragma unroll
      for (int j = 0; j < 2; ++j) acc[i][j] = MFMA(b3[j], a3[i], acc[i][j]);
    __builtin_amdgcn_sched_barrier(0);
    __builtin_amdgcn_s_barrier();
    __builtin_amdgcn_sched_barrier(0);
    cur = cur == 4 * STG ? 0 : cur + 2 * STG;
    nxt = nxt == 4 * STG ? 0 : nxt + 2 * STG;
  }
  if (grp == 0) __builtin_amdgcn_s_barrier();
#undef DMA3
#pragma unroll
  for (int i = 0; i < 1; ++i)
#pragma unroll
    for (int j = 0; j < 2; ++j)
#pragma unroll
      for (int q = 0; q < 4; q += 2) {
        const int m = wm * 32 + i * 32 + l32, n = wn * 64 + j * 32 + 8 * q;
        const uint2 pa = epi(m, n + 4 * hh, acc[i][j][4 * q], acc[i][j][4 * q + 1], acc[i][j][4 * q + 2], acc[i][j][4 * q + 3]);
        const uint2 pb = epi(m, n + 8 + 4 * hh, acc[i][j][4 * q + 4], acc[i][j][4 * q + 5], acc[i][j][4 * q + 6], acc[i][j][4 * q + 7]);
        store_pair16(rowptr(m) + n, pa, pb, hh);
      }
}

DI uint2 pack4h(float a, float b, float c, float d) {
  f16x4 v;
  v[0] = (f16)a; v[1] = (f16)b; v[2] = (f16)c; v[3] = (f16)d;
  return __builtin_bit_cast(uint2, v);
}
DI void store_pair16(f16* dst, uint2 a, uint2 b, int hh) {
  const auto r0 = __builtin_amdgcn_permlane32_swap(a.x, b.x, false, false);
  const auto r1 = __builtin_amdgcn_permlane32_swap(a.y, b.y, false, false);
  uint4 o; o.x = r0[0]; o.y = r1[0]; o.z = r0[1]; o.w = r1[1];
  *(uint4*)(dst + 8 * hh) = o;
}
DI void store4h(f16* dst, float a, float b, float c, float d) {
  f16x4 v;
  v[0] = (f16)a; v[1] = (f16)b; v[2] = (f16)c; v[3] = (f16)d;
  *(f16x4*)dst = v;
}

DI void tconv_tile(char* smem, const float* src, int lds, f16* dst, int ldd, int k0, int n0) {
  float* t = (float*)smem;
  const int tid = tid_();
#pragma unroll
  for (int j = 0; j < 4; ++j) {
    const int r = (tid >> 4) + 16 * j, c4 = (tid & 15) * 4;
    const float4 v = *(const float4*)(src + (size_t)(k0 + r) * lds + n0 + c4);
    t[r * 65 + c4] = v.x; t[r * 65 + c4 + 1] = v.y; t[r * 65 + c4 + 2] = v.z; t[r * 65 + c4 + 3] = v.w;
  }
  __syncthreads();
  const int n = tid >> 2, kc = (tid & 3) * 16;
  f16x8 o0, o1;
#pragma unroll
  for (int i = 0; i < 8; ++i) { o0[i] = (f16)t[(kc + i) * 65 + n]; o1[i] = (f16)t[(kc + 8 + i) * 65 + n]; }
  f16* d = dst + (size_t)(n0 + n) * ldd + k0 + kc;
  *(f16x8*)d = o0;
  *(f16x8*)(d + 8) = o1;
  __syncthreads();
}

DI void ada_item(KP P, char* smem, int item) {
  const int tid = tid_(), lane = tid & 63, wave = tid >> 6;
  const int layer = item / 96, rem = item % 96, cb = rem >> 2, kc = rem & 3;
  float* sc = (float*)smem;
  float* red = (float*)smem + 1280;
  for (int i = tid; i < 1280; i += 256) {
    const int j = i >> 8, k = kc * 256 + (i & 255);
    const float v = j == 0 ? P->c_ctx[k] : P->c[(j - 1) * 1024 + k];
    sc[i] = v / (1.f + __expf(-v));
  }
  __syncthreads();
  float a[5][4];
#pragma unroll
  for (int j = 0; j < 5; ++j)
#pragma unroll
    for (int e = 0; e < 4; ++e) a[j][e] = 0.f;
  const float* w = P->ada_w + ((size_t)layer * 1024 + kc * 256 + wave * 64) * 6144 + cb * 256 + lane * 4;
#pragma unroll 8
  for (int i = 0; i < 64; ++i) {
    const float4 v = *(const float4*)(w + (size_t)i * 6144);
#pragma unroll
    for (int j = 0; j < 5; ++j) {
      const float s = sc[j * 256 + wave * 64 + i];
      a[j][0] += s * v.x; a[j][1] += s * v.y; a[j][2] += s * v.z; a[j][3] += s * v.w;
    }
  }
#pragma unroll
  for (int j = 0; j < 5; ++j)
#pragma unroll
    for (int e = 0; e < 4; ++e) red[(wave * 5 + j) * 256 + lane * 4 + e] = a[j][e];
  __syncthreads();
  float* adap = (float*)(P->ws + WS_ADAP);
#pragma unroll
  for (int j = 0; j < 5; ++j) {
    const float s = red[(0 * 5 + j) * 256 + tid] + red[(1 * 5 + j) * 256 + tid] + red[(2 * 5 + j) * 256 + tid] +
                    red[(3 * 5 + j) * 256 + tid];
    adap[((layer * 4 + kc) * 5 + j) * 6144 + cb * 256 + tid] = s;
  }
  __syncthreads();
}

DI void const_item(KP P, int item) {
  f16* fc = (f16*)(P->ws + WS_FC);
  f16* d256 = (f16*)(P->ws + WS_D256);
  f16* f64 = (f16*)(P->ws + WS_F64);
  f16* ds = (f16*)(P->ws + WS_DS);
#pragma unroll 1
  for (int j = 0; j < 8; ++j) {
    int e = item * 2048 + j * 256 + tid_();
    float sn, cs;
    if (e < 32768) {
      const int m = e >> 7, c = e & 127, l = m >> 1, ri = m & 1;
      sincospif((float)((l * c) & 127) * (1.f / 64.f), &sn, &cs);
      fc[e] = (f16)((ri ? -sn : cs) * 0.08838834764831845f);
    } else if (e < 32768 + 131072) {
      e -= 32768;
      const int k = e >> 9, col = e & 511, ri = col >> 8, s = col & 255;
      sincospif((float)((k * s) & 255) * (1.f / 128.f), &sn, &cs);
      d256[e] = (f16)((ri ? sn : cs) * 0.0625f);
    } else if (e < 32768 + 131072 + 16384) {
      e -= 32768 + 131072;
      const int n = e >> 7, col = e & 127, rip = n >> 6, k2 = n & 63, ri = col >> 6, s2 = col & 63;
      sincospif((float)((k2 * s2) & 63) * (1.f / 32.f), &sn, &cs);
      f64[e] = (f16)((rip == ri ? cs : (rip == 0 ? sn : -sn)) * 0.125f);
    } else {
      e -= 32768 + 131072 + 16384;
      const int k = e >> 7, col = e & 127, ri = col >> 6, s1 = col & 63;
      sincospif((float)((k * s1) & 4095) * (1.f / 2048.f), &sn, &cs);
      ds[e] = (f16)((ri ? sn : cs) * 0.125f);
    }
  }
}

DI void phase_prep(KP P, char* smem) {
  constexpr int NADA = 192, NTC = 5792, NCONST = 344;
  smem += half_() * kHalfLds;
  for (int it = blockIdx.x * 2 + half_(); it < NADA + NTC + NCONST; it += gridDim.x * 2) {
    if (it < NADA) {
      ada_item(P, smem, it);
    } else if (it < NADA + NTC) {
      int i = it - NADA;
      const float* src; f16* dst; int K, N;
      if (i < 384) { src = P->e_w_in; dst = (f16*)(P->ws + WS_WIN); K = 1024; N = 1536; }
      else if (i < 640) { i -= 384; src = P->e_w_out; dst = (f16*)(P->ws + WS_WOUT0); K = 1024; N = 1024; }
      else if (i < 2688) { i -= 640; const int l = i >> 10; i &= 1023; src = P->w1 + (size_t)l * 1024 * 4096; dst = (f16*)(P->ws + WS_W1) + (size_t)l * 4096 * 1024; K = 1024; N = 4096; }
      else if (i < 4736) { i -= 2688; const int l = i >> 10; i &= 1023; src = P->w2 + (size_t)l * 4096 * 1024; dst = (f16*)(P->ws + WS_W2) + (size_t)l * 1024 * 4096; K = 4096; N = 1024; }
      else if (i < 5504) { i -= 4736; src = P->o_w_qkv; dst = (f16*)(P->ws + WS_WQKV); K = 1024; N = 3072; }
      else if (i < 5760) { i -= 5504; src = P->o_w_out; dst = (f16*)(P->ws + WS_WO1); K = 1024; N = 1024; }
      else {
        i -= 5760;
        const int hb = i & 7, ri = (i >> 3) & 1, d = i >> 4;
        src = (ri ? P->e_w_i : P->e_w_r) + (size_t)(d * 8 + hb) * 4096;
        dst = (f16*)(P->ws + WS_GW) + (size_t)i * 4096;
        K = 64; N = 64; i = 0;
      }
      const int ntn = N >> 6;
      tconv_tile(smem, src, N, dst, K, (i / ntn) * 64, (i % ntn) * 64);
    } else {
      const_item(P, it - NADA - NTC);
    }
  }
}

#define DPP_ADD(v, ctrl) ((v) + __builtin_bit_cast(float, __builtin_amdgcn_update_dpp(0, __builtin_bit_cast(int, (v)), (ctrl), 0xF, 0xF, true)))
DI float wave_allsum_dpp(float v) {
  v = DPP_ADD(v, 0xB1);
  v = DPP_ADD(v, 0x4E);
  v = DPP_ADD(v, 0x141);
  v = DPP_ADD(v, 0x140);
  const unsigned u = __builtin_bit_cast(unsigned, v);
  const auto r16 = __builtin_amdgcn_permlane16_swap(u, u, false, false);
  v = __builtin_bit_cast(float, (unsigned)r16[0]) + __builtin_bit_cast(float, (unsigned)r16[1]);
  const unsigned w = __builtin_bit_cast(unsigned, v);
  const auto r32 = __builtin_amdgcn_permlane32_swap(w, w, false, false);
  return __builtin_bit_cast(float, (unsigned)r32[0]) + __builtin_bit_cast(float, (unsigned)r32[1]);
}
constexpr int LNB = 5;
DI void wave_sum_n(float (&s)[LNB]) {
#pragma unroll
  for (int o = 32; o; o >>= 1)
#pragma unroll
    for (int r = 0; r < LNB; ++r) s[r] += __shfl_xor(s[r], o);
}
DI void ln_stats(float (&v)[LNB][16], float (&rstd)[LNB]) {
  float s[LNB], s2[LNB];
#pragma unroll
  for (int r = 0; r < LNB; ++r) {
    s[r] = 0.f; s2[r] = 0.f;
#pragma unroll
    for (int k = 0; k < 16; ++k) { s[r] += v[r][k]; s2[r] = fmaf(v[r][k], v[r][k], s2[r]); }
  }
#pragma unroll
  for (int r = 0; r < LNB; ++r) { s[r] = wave_allsum_dpp(s[r]); s2[r] = wave_allsum_dpp(s2[r]); }
#pragma unroll
  for (int r = 0; r < LNB; ++r) {
    const float mean = s[r] * (1.f / 1024.f);
    const float var = fmaxf(s2[r] * (1.f / 1024.f) - mean * mean, 0.f);
    rstd[r] = rsqrtf(var + 1e-5f);
#pragma unroll
    for (int k = 0; k < 16; ++k) v[r][k] -= mean;
  }
}

template <bool SRC_INPUT, bool HAS_LN, bool HAS_MOD, bool DST_OUT>
DI void phase_ln(KP P, const float* g_, const float* b_, int layer, int shift_idx, int scale_idx) {
  const int tid = tidf_(), lane = tid & 63, wave = tid >> 6;
  if (SRC_INPUT) {
    const int e = blockIdx.x * 512 + tid;
    if (e < 2 * 5 * 6144) {
      const int layer_ = e / 30720, rem = e % 30720;
      ((float*)(P->ws + WS_ADAF))[e] = ada_val(P, layer_, rem / 6144, rem % 6144);
    }
  }
  f16* xr = (f16*)(P->ws + WS_XR);
  f16* hbuf = (f16*)(P->ws + WS_H);
  const int nw = gridDim.x * 8, rpw = (T + nw - 1) / nw;
  const int r_begin = (blockIdx.x * 8 + wave) * rpw, r_end = min(T, r_begin + rpw);
  float g[16], bb[16], sc[16], sh[16];
#pragma unroll
  for (int k = 0; k < 16; ++k) {
    const int col = (k >> 2) * 256 + lane * 4 + (k & 3);
    if (HAS_LN) { g[k] = g_[col]; bb[k] = b_[col]; } else { g[k] = 1.f; bb[k] = 0.f; }
    sc[k] = 1.f; sh[k] = 0.f;
  }
  int cur = -1;
#pragma unroll 1
  for (int t = r_begin; t < r_end; t += LNB) {
    float v[LNB][16], rstd[LNB];
#pragma unroll
    for (int r = 0; r < LNB; ++r) {
      const int tt = min(t + r, r_end - 1);
      if (SRC_INPUT) {
        const float* src = tt < TP ? P->x_prompt + (size_t)tt * 1024 : P->x_sample + (size_t)(tt - TP) * 1024;
#pragma unroll
        for (int j = 0; j < 4; ++j) {
          const float4 q = *(const float4*)(src + j * 256 + lane * 4);
          v[r][j * 4] = q.x; v[r][j * 4 + 1] = q.y; v[r][j * 4 + 2] = q.z; v[r][j * 4 + 3] = q.w;
        }
      } else {
#pragma unroll
        for (int j = 0; j < 4; ++j) {
          const f16x4 q = *(const f16x4*)(xr + (size_t)tt * 1024 + j * 256 + lane * 4);
          v[r][j * 4] = (float)q[0]; v[r][j * 4 + 1] = (float)q[1]; v[r][j * 4 + 2] = (float)q[2]; v[r][j * 4 + 3] = (float)q[3];
        }
      }
    }
    ln_stats(v, rstd);
    if (HAS_LN) {
#pragma unroll
      for (int r = 0; r < LNB; ++r) {
#pragma unroll
        for (int k = 0; k < 16; ++k) v[r][k] = v[r][k] * rstd[r] * g[k] + bb[k];
        if (t + r < r_end) {
          if (DST_OUT) {
            float* dst = P->out + (size_t)(t + r) * 1024;
#pragma unroll
            for (int j = 0; j < 4; ++j) {
              float4 q; q.x = v[r][j * 4]; q.y = v[r][j * 4 + 1]; q.z = v[r][j * 4 + 2]; q.w = v[r][j * 4 + 3];
              *(float4*)(dst + j * 256 + lane * 4) = q;
            }
          } else {
#pragma unroll
            for (int j = 0; j < 4; ++j)
              store4h(xr + (size_t)(t + r) * 1024 + j * 256 + lane * 4, v[r][j * 4], v[r][j * 4 + 1], v[r][j * 4 + 2], v[r][j * 4 + 3]);
          }
        }
      }
      if (HAS_MOD) ln_stats(v, rstd);
    }
    if (HAS_MOD) {
#pragma unroll
      for (int r = 0; r < LNB; ++r) {
        if (t + r < r_end) {
          const int cond = cond_of(t + r);
          if (cond != cur) {
            cur = cond;
#pragma unroll
            for (int k = 0; k < 16; ++k) {
              const int col = (k >> 2) * 256 + lane * 4 + (k & 3);
              sh[k] = SRC_INPUT ? ada_val(P, layer, cond, shift_idx * 1024 + col) : adaf(P, layer, cond, shift_idx * 1024 + col);
              sc[k] = 1.f + (SRC_INPUT ? ada_val(P, layer, cond, scale_idx * 1024 + col) : adaf(P, layer, cond, scale_idx * 1024 + col));
            }
          }
          f16* hd = hbuf + (size_t)(t + r) * 1024;
#pragma unroll
          for (int j = 0; j < 4; ++j)
            store4h(hd + j * 256 + lane * 4, v[r][j * 4] * rstd[r] * sc[j * 4] + sh[j * 4], v[r][j * 4 + 1] * rstd[r] * sc[j * 4 + 1] + sh[j * 4 + 1],
                    v[r][j * 4 + 2] * rstd[r] * sc[j * 4 + 2] + sh[j * 4 + 2], v[r][j * 4 + 3] * rstd[r] * sc[j * 4 + 3] + sh[j * 4 + 3]);
        }
      }
    }
  }
}

DI void scan_item(KP P, char* smem, int item, int mode) {
  const int tid = tid_(), lane = tid & 63, wave = tid >> 6, l32 = lane & 31, hh = lane >> 5;
  const int c = item >> 3, hb = item & 7;
  const int t0 = c * 64;
  const bool ctx = c < 64;
  const int bstart = ctx ? (c >> 2) * 256 : TP + ((c - 64) >> 6) * 4096;
  const int bend = bstart + (ctx ? 256 : 4096);
  const f16* u = (const f16*)(P->ws + WS_B1);
  float2* sum = (float2*)(P->ws + WS_SUM);
  float hcarry = 0.f;
  if (mode == 1) {
    const int cfirst = ctx ? (c & ~3) : 64 + ((c - 64) & ~63);
    const int clast = ctx ? (c | 3) : 64 + ((c - 64) | 63);
    const int nf = c - cfirst, nb = clast - c;
    float2* car = (float2*)smem;
    for (int idx = tid; idx < (nf + nb) * 64; idx += 256) {
      const int q = idx >> 6, nn = idx & 63;
      car[idx] = q < nf ? sum[(size_t)((cfirst + q) * 2) * 512 + hb * 64 + nn]
                        : sum[(size_t)((clast - (q - nf)) * 2 + 1) * 512 + hb * 64 + nn];
    }
    __syncthreads();
    if (tid < 128) {
      const int dd = tid >> 6, nn = tid & 63;
      const int lb = ctx ? 0 : ((c - 64) >> 6);
      float h = ctx ? 0.f : P->state_lru[(lb * 2 + dd) * 512 + hb * 64 + nn];
      const int q0 = dd ? nf : 0, q1 = dd ? nf + nb : nf;
#pragma unroll 4
      for (int q = q0; q < q1; ++q) { const float2 sv = car[q * 64 + nn]; h = sv.x * h + sv.y; }
      hcarry = h;
    }
    __syncthreads();
  }
  {
    const int tok = tid >> 2, cb = (tid & 3) * 16, t = t0 + tok, ch0 = hb * 64 + cb;
    float acc[16];
#pragma unroll
    for (int i = 0; i < 4; ++i) {
      const float4 q = *(const float4*)(P->e_conv_b + ch0 + 4 * i);
      acc[4 * i] = q.x; acc[4 * i + 1] = q.y; acc[4 * i + 2] = q.z; acc[4 * i + 3] = q.w;
    }
#pragma unroll
    for (int k = 0; k < 4; ++k) {
      const int tt = t + k - 2;
      if (tt >= bstart && tt < bend) {
        const f16x8 x0 = *(const f16x8*)(u + (size_t)tt * 1536 + ch0);
        const f16x8 x1 = *(const f16x8*)(u + (size_t)tt * 1536 + ch0 + 8);
        float xv[16];
#pragma unroll
        for (int i = 0; i < 8; ++i) { xv[i] = (float)x0[i]; xv[8 + i] = (float)x1[i]; }
#pragma unroll
        for (int i = 0; i < 4; ++i) {
          const float4 wq = *(const float4*)(P->e_conv_w + k * 512 + ch0 + 4 * i);
          acc[4 * i] += wq.x * xv[4 * i]; acc[4 * i + 1] += wq.y * xv[4 * i + 1];
          acc[4 * i + 2] += wq.z * xv[4 * i + 2]; acc[4 * i + 3] += wq.w * xv[4 * i + 3];
        }
      }
    }
    f16x8 o0, o1;
#pragma unroll
    for (int i = 0; i < 8; ++i) { o0[i] = (f16)acc[i]; o1[i] = (f16)acc[8 + i]; }
    *(f16x8*)(smem + tok * 144 + cb * 2) = o0;
    *(f16x8*)(smem + tok * 144 + cb * 2 + 16) = o1;
  }
  {
    const f16* gw = (const f16*)(P->ws + WS_GW);
#pragma unroll
    for (int i = 0; i < 8; ++i) {
      const int id = tid + 256 * i, mat = id >> 9, rem = id & 511, n = rem >> 3, ch = rem & 7;
      const uint4 v = *(const uint4*)(gw + (size_t)(mat * 8 + hb) * 4096 + n * 64 + ch * 8);
      *(uint4*)(smem + 9216 + mat * 9216 + n * 144 + ch * 16) = v;
    }
  }
  __syncthreads();
  const int d = wave >> 1, nh = wave & 1;
  const int n = nh * 32 + l32, ch = hb * 64 + n;
  f32x16 accr0, accr1, acci0, acci1;
#pragma unroll
  for (int i = 0; i < 16; ++i) { accr0[i] = 0.f; accr1[i] = 0.f; acci0[i] = 0.f; acci1[i] = 0.f; }
#pragma unroll
  for (int ks = 0; ks < 4; ++ks) {
    const int ko = (ks * 16 + hh * 8) * 2;
    const f16x8 a0 = *(const f16x8*)(smem + l32 * 144 + ko);
    const f16x8 a1 = *(const f16x8*)(smem + (32 + l32) * 144 + ko);
    const f16x8 br = *(const f16x8*)(smem + 9216 + (d * 2) * 9216 + n * 144 + ko);
    const f16x8 bi = *(const f16x8*)(smem + 9216 + (d * 2 + 1) * 9216 + n * 144 + ko);
    accr0 = MFMA(a0, br, accr0);
    accr1 = MFMA(a1, br, accr1);
    acci0 = MFMA(a0, bi, acci0);
    acci1 = MFMA(a1, bi, acci1);
  }
  float xcv0[16], xcv1[16];
#pragma unroll
  for (int r = 0; r < 16; ++r) {
    xcv0[r] = (float)*(const f16*)(smem + crow(r, hh) * 144 + n * 2);
    xcv1[r] = (float)*(const f16*)(smem + (32 + crow(r, hh)) * 144 + n * 2);
  }
  __syncthreads();
  {
    const float brv = P->e_b_r[d * 512 + ch], biv = P->e_b_i[d * 512 + ch];
    const float sp = log1pf(__expf(-P->e_lam[d * 512 + ch]));
    float* as = (float*)smem + d * 4096;
    float* bs = (float*)smem + 8192 + d * 4096;
#pragma unroll
    for (int r = 0; r < 16; ++r) {
      {
        const int tok = crow(r, hh);
        const float rr = sigmoidf_(accr0[r] + brv), ii = sigmoidf_(acci0[r] + biv);
        const float la = -8.f * rr * sp;
        const float av = __expf(la);
        as[tok * 64 + n] = av;
        bs[tok * 64 + n] = __builtin_amdgcn_sqrtf(fmaxf(fmaf(-av, av, 1.f), 0.f)) * ii * xcv0[r];
      }
      {
        const int tok = 32 + crow(r, hh);
        const float rr = sigmoidf_(accr1[r] + brv), ii = sigmoidf_(acci1[r] + biv);
        const float la = -8.f * rr * sp;
        const float av = __expf(la);
        as[tok * 64 + n] = av;
        bs[tok * 64 + n] = __builtin_amdgcn_sqrtf(fmaxf(fmaf(-av, av, 1.f), 0.f)) * ii * xcv1[r];
      }
    }
  }
  __syncthreads();
  if (tid < 128) {
    const int dd = tid >> 6, nn = tid & 63, cc_ = hb * 64 + nn;
    const float* as = (const float*)smem + dd * 4096 + nn;
    float* bs = (float*)smem + 8192 + dd * 4096 + nn;
    float h = hcarry, p = 1.f;
#pragma unroll 1
    for (int blk = 0; blk < 8; ++blk) {
      const int tb = dd ? 56 - blk * 8 : blk * 8;
      float av[8], bv[8];
#pragma unroll
      for (int i = 0; i < 8; ++i) { av[i] = as[(tb + i) * 64]; bv[i] = bs[(tb + i) * 64]; }
      if (dd == 0) {
#pragma unroll
        for (int i = 0; i < 8; ++i) { h = av[i] * h + bv[i]; p *= av[i]; bv[i] = h; }
      } else {
#pragma unroll
        for (int i = 7; i >= 0; --i) { h = av[i] * h + bv[i]; p *= av[i]; bv[i] = h; }
      }
      if (mode == 1) {
#pragma unroll
        for (int i = 0; i < 8; ++i) bs[(tb + i) * 64] = bv[i];
      }
    }
    if (mode == 0) {
      sum[(size_t)(c * 2 + dd) * 512 + cc_] = make_float2(p, h);
    } else if (ctx) {
      if (dd == 0 && (c & 3) == 3) P->out[OUT_LRU + ((c >> 2) * 2 + 0) * 512 + cc_] = h;
      if (dd == 1 && (c & 3) == 0) P->out[OUT_LRU + ((c >> 2) * 2 + 1) * 512 + cc_] = h;
    }
  }
  __syncthreads();
  if (mode == 1) {
    const int tok = tid >> 2, cb = (tid & 3) * 16, t = t0 + tok;
    const float* hf = (const float*)smem + 8192 + tok * 64 + cb;
    const float* hbw = hf + 4096;
    const f16x8 g0 = *(const f16x8*)(u + (size_t)t * 1536 + 512 + hb * 64 + cb);
    const f16x8 g1 = *(const f16x8*)(u + (size_t)t * 1536 + 512 + hb * 64 + cb + 8);
    f16x8 o0, o1;
#pragma unroll
    for (int i = 0; i < 8; ++i) {
      float x = (float)g0[i];
      float gl = x * sigmoidf_(1.5957691216057308f * (x + 0.044715f * x * x * x));
      o0[i] = (f16)((hf[i] + hbw[i]) * gl);
      x = (float)g1[i];
      gl = x * sigmoidf_(1.5957691216057308f * (x + 0.044715f * x * x * x));
      o1[i] = (f16)((hf[8 + i] + hbw[8 + i]) * gl);
    }
    f16* yc = (f16*)(P->ws + WS_H) + (size_t)t * 1024 + hb * 64 + cb;
    *(f16x8*)yc = o0;
    *(f16x8*)(yc + 8) = o1;
    __syncthreads();
  }
}

template <int MODE>
DI void attn_tile(const char* kb_, const char* vb_, const char* bt, const int (&bi0)[16], const int (&bi1)[16], const f16x8 q0,
                  const f16x8 q1, const f16x8 q2, const f16x8 q3, float& m, float& lsum, f32x16& o0, f32x16& o1, int l32, int hh, int rsw) {
#define LIVE0(r) (MODE != 2 || (r) >= 12)
#define LIVE1(r) (MODE != 1 || (r) < 4)
  f32x16 s0, s1;
#pragma unroll
  for (int i = 0; i < 16; ++i) { s0[i] = 0.f; s1[i] = 0.f; }
  {
    int co = ((0 + hh) ^ rsw) << 4;
    s0 = MFMA(*(const f16x8*)(kb_ + l32 * 128 + co), q0, s0);
    s1 = MFMA(*(const f16x8*)(kb_ + (32 + l32) * 128 + co), q0, s1);
    co = ((2 + hh) ^ rsw) << 4;
    s0 = MFMA(*(const f16x8*)(kb_ + l32 * 128 + co), q1, s0);
    s1 = MFMA(*(const f16x8*)(kb_ + (32 + l32) * 128 + co), q1, s1);
    co = ((4 + hh) ^ rsw) << 4;
    s0 = MFMA(*(const f16x8*)(kb_ + l32 * 128 + co), q2, s0);
    s1 = MFMA(*(const f16x8*)(kb_ + (32 + l32) * 128 + co), q2, s1);
    co = ((6 + hh) ^ rsw) << 4;
    s0 = MFMA(*(const f16x8*)(kb_ + l32 * 128 + co), q3, s0);
    s1 = MFMA(*(const f16x8*)(kb_ + (32 + l32) * 128 + co), q3, s1);
  }
  if (MODE != 0) {
#pragma unroll
    for (int r = 0; r < 16; ++r) {
      if (LIVE0(r)) s0[r] += *(const float*)(bt + bi0[r]);
      if (LIVE1(r)) s1[r] += *(const float*)(bt + bi1[r]);
    }
  }
  float mx = -INFINITY;
#pragma unroll
  for (int r = 0; r < 16; ++r) {
    if (LIVE0(r)) mx = fmaxf(mx, s0[r]);
    if (LIVE1(r)) mx = fmaxf(mx, s1[r]);
  }
  {
    const unsigned mu = __builtin_bit_cast(unsigned, mx);
    const auto mr = __builtin_amdgcn_permlane32_swap(mu, mu, false, false);
    mx = fmaxf(__builtin_bit_cast(float, (unsigned)mr[0]), __builtin_bit_cast(float, (unsigned)mr[1]));
  }
  const float mn = fmaxf(m, mx);
  const float alpha = __builtin_amdgcn_exp2f(m - mn);
  m = mn;
  float ps0 = 0.f, ps1 = 0.f;
#pragma unroll
  for (int r = 0; r < 16; ++r) {
    if (LIVE0(r)) { s0[r] = __builtin_amdgcn_exp2f(s0[r] - mn); ps0 += s0[r]; } else s0[r] = 0.f;
    if (LIVE1(r)) { s1[r] = __builtin_amdgcn_exp2f(s1[r] - mn); ps1 += s1[r]; } else s1[r] = 0.f;
  }
  lsum = lsum * alpha + (ps0 + ps1);
  if (__any(alpha != 1.f)) {
#pragma unroll
    for (int r = 0; r < 16; ++r) { o0[r] *= alpha; o1[r] *= alpha; }
  }
#pragma unroll
  for (int kb = 0; kb < 2; ++kb)
#pragma unroll
    for (int st = 0; st < 2; ++st) {
      if ((MODE == 1 && kb == 1 && st == 1) || (MODE == 2 && kb == 0 && st == 0)) continue;
      typedef __attribute__((ext_vector_type(2))) __fp16 h2_t;
      typedef __attribute__((ext_vector_type(4))) unsigned u4_t;
      u4_t pu;
#pragma unroll
      for (int e = 0; e < 4; ++e) {
        const h2_t hv = kb == 0 ? __builtin_amdgcn_cvt_pkrtz(s0[8 * st + 2 * e], s0[8 * st + 2 * e + 1])
                                : __builtin_amdgcn_cvt_pkrtz(s1[8 * st + 2 * e], s1[8 * st + 2 * e + 1]);
        pu[e] = __builtin_bit_cast(unsigned, hv);
      }
      const f16x8 pf = __builtin_bit_cast(f16x8, pu);
      const int c0 = ((4 * kb + 2 * st) ^ rsw) << 4, c1 = ((4 * kb + 2 * st + 1) ^ rsw) << 4;
      {
        const f16x4 lo = *(const f16x4*)(vb_ + l32 * 128 + c0 + 8 * hh);
        const f16x4 hi = *(const f16x4*)(vb_ + l32 * 128 + c1 + 8 * hh);
        const f16x8 va = __builtin_shufflevector(lo, hi, 0, 1, 2, 3, 4, 5, 6, 7);
        o0 = MFMA(va, pf, o0);
      }
      {
        const f16x4 lo = *(const f16x4*)(vb_ + (32 + l32) * 128 + c0 + 8 * hh);
        const f16x4 hi = *(const f16x4*)(vb_ + (32 + l32) * 128 + c1 + 8 * hh);
        const f16x8 va = __builtin_shufflevector(lo, hi, 0, 1, 2, 3, 4, 5, 6, 7);
        o1 = MFMA(va, pf, o1);
      }
    }
#undef LIVE0
#undef LIVE1
}

DI void attn_item(KP P, char* smem, int item) {
  constexpr int NS = 6, PD = 4;
  const int tid = tidf_(), lane = tid & 63, wave = tid >> 6, l32 = lane & 31, hh = lane >> 5;
  const int sub = wave >> 1, sw = wave & 1;
  float* rpbs = (float*)(smem + NS * 16384);
  const bool latent = item < 1024;
  const int sid = (latent ? item : item - 1024) * 4 + sub;
  const f16* qbuf = (const f16*)(P->ws + WS_B1);
  const f16* kbuf = qbuf + (size_t)T * 1024;
  const char* b2 = (const char*)P->out;
  int b, h, row = 0, rs = 0, qtok0, ntiles, nloc = 0, a0 = 0;
  if (latent) {
    b = sid >> 10; h = (sid >> 6) & 15; row = sid & 63; rs = min(max(row - 4, 0), 56); qtok0 = TP + b * 4096 + row * 64;
    const int r0 = row & ~3;
    a0 = min(max(r0 - 4, 0), 56);
    const int a1 = min(max(r0 - 1, 0), 56) + 7;
    nloc = a1 - a0 + 1; ntiles = nloc + 8;
  } else { b = sid >> 6; h = (sid >> 2) & 15; qtok0 = b * 256 + (sid & 3) * 64; ntiles = 4; }
  const int drow = wave * 8 + (lane >> 3), dch = ((lane & 7) ^ ((drow >> 1) & 7)) * 8;
  const int dlds = wave * 1024 + lane * 16;
  auto dma = [&](int j) {
    const f16 *kp, *vp; size_t kst, vst;
    if (latent) {
      if (j < nloc) {
        kp = kbuf + (size_t)(TP + b * 4096 + (a0 + j) * 64) * 1024 + h * 64; kst = 1024;
        vp = (const f16*)(b2 + B2_VTL) + (size_t)((b * 16 + h) * 64) * 4096 + (a0 + j) * 64; vst = 4096;
      } else {
        kp = (const f16*)(b2 + B2_CK) + (size_t)((b * 16 + h) * 512 + (j - nloc) * 64) * 64; kst = 64;
        vp = (const f16*)(b2 + B2_CVT) + (size_t)((b * 16 + h) * 64) * 512 + (j - nloc) * 64; vst = 512;
      }
    } else {
      kp = kbuf + (size_t)(b * 256 + j * 64) * 1024 + h * 64; kst = 1024;
      vp = (const f16*)(b2 + B2_VTC) + (size_t)((b * 16 + h) * 64) * 256 + j * 64; vst = 256;
    }
    char* st = smem + (j % NS) * 16384;
    __builtin_amdgcn_global_load_lds((const void*)(kp + (size_t)drow * kst + dch), (LAS void*)(st + dlds), 16, 0, 0);
    __builtin_amdgcn_global_load_lds((const void*)(vp + (size_t)drow * vst + dch), (LAS void*)(st + 8192 + dlds), 16, 0, 0);
  };
#pragma unroll
  for (int j = 0; j < PD; ++j) if (j < ntiles) dma(j);
  if (latent) for (int i = tid; i < 480; i += 512) { const int rr = i >> 5, cc = i & 31; rpbs[i] = cc < 31 ? P->o_rpb[h * 465 + rr * 31 + cc] * LOG2E : -INFINITY; }
  const int qc = sw * 32 + l32;
  const f16* qp = qbuf + (size_t)(qtok0 + qc) * 1024 + h * 64 + hh * 8;
  const f16x8 q0 = *(const f16x8*)qp, q1 = *(const f16x8*)(qp + 16), q2 = *(const f16x8*)(qp + 32), q3 = *(const f16x8*)(qp + 48);
  __syncthreads();
  float m = -INFINITY, lsum = 0.f;
  f32x16 o0, o1;
#pragma unroll
  for (int i = 0; i < 16; ++i) { o0[i] = 0.f; o1[i] = 0.f; }
  const int rsw = (l32 >> 1) & 7;
  const int cs = min(max(qc - 8, 0), 48);
  int bi0[16], bi1[16];
#pragma unroll
  for (int r = 0; r < 16; ++r) {
    const int k0 = crow(r, hh), k1 = 32 + k0;
    bi0[r] = ((k0 >= cs && k0 < cs + 16) ? (k0 - qc + 15) : 31) * 4;
    bi1[r] = ((k1 >= cs && k1 < cs + 16) ? (k1 - qc + 15) : 31) * 4;
  }
#pragma unroll 1
  for (int j = 0; j < ntiles; ++j) {
    if (j + PD < ntiles) dma(j + PD);
    {
      const int ahead = min(PD, ntiles - 1 - j);
      if (ahead >= 4) asm volatile("s_waitcnt vmcnt(8)" ::: "memory");
      else if (ahead == 3) asm volatile("s_waitcnt vmcnt(6)" ::: "memory");
      else if (ahead == 2) asm volatile("s_waitcnt vmcnt(4)" ::: "memory");
      else if (ahead == 1) asm volatile("s_waitcnt vmcnt(2)" ::: "memory");
      else asm volatile("s_waitcnt vmcnt(0)" ::: "memory");
    }
    __builtin_amdgcn_s_barrier();
    __builtin_amdgcn_sched_barrier(0);
    const char* kb_ = smem + (j % NS) * 16384;
    const char* vb_ = kb_ + 8192;
    const bool act = !latent || j >= nloc || (a0 + j >= rs && a0 + j <= rs + 7);
    if (act) {
      if (latent && j < nloc) {
        const char* bt = (const char*)rpbs + (a0 + j - row + 7) * 128;
        if (sw == 0) attn_tile<1>(kb_, vb_, bt, bi0, bi1, q0, q1, q2, q3, m, lsum, o0, o1, l32, hh, rsw);
        else attn_tile<2>(kb_, vb_, bt, bi0, bi1, q0, q1, q2, q3, m, lsum, o0, o1, l32, hh, rsw);
      } else {
        attn_tile<0>(kb_, vb_, nullptr, bi0, bi1, q0, q1, q2, q3, m, lsum, o0, o1, l32, hh, rsw);
      }
    }
  }
  __syncthreads();
  float inv;
  {
    const unsigned lu = __builtin_bit_cast(unsigned, lsum);
    const auto lr_ = __builtin_amdgcn_permlane32_swap(lu, lu, false, false);
    inv = 1.f / (__builtin_bit_cast(float, (unsigned)lr_[0]) + __builtin_bit_cast(float, (unsigned)lr_[1]));
  }
  f16* op = (f16*)(P->ws + WS_H) + (size_t)(qtok0 + qc) * 1024 + h * 64;
#pragma unroll
  for (int q = 0; q < 4; ++q) {
    store4h(op + 8 * q + 4 * hh, o0[4 * q] * inv, o0[4 * q + 1] * inv, o0[4 * q + 2] * inv, o0[4 * q + 3] * inv);
    store4h(op + 32 + 8 * q + 4 * hh, o1[4 * q] * inv, o1[4 * q + 1] * inv, o1[4 * q + 2] * inv, o1[4 * q + 3] * inv);
  }
}

struct TileIter {
  int lt, step, nt, x;
  DI TileIter(int NT) {
    nt = NT;
    if (gridDim.x == 256) { x = blockIdx.x & 7; lt = blockIdx.x >> 3; step = 32; }
    else { x = -1; lt = blockIdx.x; step = gridDim.x; }
  }
  DI bool valid() const { return lt < (x >= 0 ? 10 * nt : 80 * nt); }
  DI int tm() const { return x >= 0 ? x + 8 * (lt / nt) : lt / nt; }
  DI int tn() const { return lt % nt; }
  DI void next() { lt += step; }
};

DI void phase_gin(KP P, char* smem) {
  const f16* hb = (const f16*)(P->ws + WS_H);
  const f16* w = (const f16*)(P->ws + WS_WIN);
  f16* u = (f16*)(P->ws + WS_B1);
  for (TileIter ti(6); ti.valid(); ti.next()) {
    const int tm = ti.tm(), tn = ti.tn();
    gemm8w<256, true, true>(smem, 1024, [&](int r) { return hb + (size_t)(tm * 256 + r) * 1024; },
              [&](int r) { return w + (size_t)(tn * 256 + r) * 1024; },
              [&](int m, int n, float v0, float v1, float v2, float v3) {
                const float4 bias = *(const float4*)(P->e_b_in + tn * 256 + n);
                return pack4h(v0 + bias.x, v1 + bias.y, v2 + bias.z, v3 + bias.w);
              }, [&](int m) { return u + (size_t)(tm * 256 + m) * 1536 + tn * 256; });
  }
}

DI void g1_tile(KP P, char* smem, int tile) {
  const int g = tile & 3, nt = (tile >> 2) & 1, mt = tile >> 3;
  const f16* u = (const f16*)(P->ws + WS_B1);
  const f16* fc = (const f16*)(P->ws + WS_FC);
  char* b2 = (char*)P->out;
  gemm_tile<true>(smem, 128,
            [&](int r) {
              const int m = mt * 256 + r;
              int tok = m;
              if (m >= TP) { const int lm = m - TP; tok = TP + (lm & ~4095) + ((lm >> 6) & 63) + 64 * (lm & 63); }
              return u + (size_t)tok * 1536 + 1024 + g * 128;
            },
            [&](int r) { return fc + (size_t)(nt * 128 + r) * 128; },
            [&](int m_, int n_, float v0, float v1, float v2, float v3) {
              const int m = mt * 256 + m_, n = nt * 128 + n_, l = n >> 1;
              f16* d;
              size_t ls, rs_;
              if (m < TP) {
                const int b = m >> 8, s_ = m & 255;
                d = (f16*)(b2 + B2_W1C) + ((size_t)((b * 4 + g) * 128 + l) * 512 + s_); ls = 512; rs_ = 256;
              } else {
                const int lm = m - TP, b = lm >> 12, s1 = (lm >> 6) & 63, s2 = lm & 63;
                d = (f16*)(b2 + B2_W1L) + ((size_t)(((b * 4 + g) * 128 + l) * 64 + s1) * 128 + s2); ls = 64 * 128; rs_ = 64;
              }
              d[0] = (f16)v0; d[rs_] = (f16)v1; d[ls] = (f16)v2; d[ls + rs_] = (f16)v3;
            });
}

DI void ct1_tile(KP P, char* smem, int mt) {
  char* b2 = (char*)P->out;
  const f16* w1l = (const f16*)(b2 + B2_W1L);
  const f16* f64 = (const f16*)(P->ws + WS_F64);
  f16* z = (f16*)(b2 + B2_Z);
  gemm_tile<true>(smem, 128, [&](int r) { return w1l + (size_t)(mt * 256 + r) * 128; }, [&](int r) { return f64 + (size_t)r * 128; },
            [&](int m_, int n, float v0, float v1, float v2, float v3) {
              const int m = mt * 256 + m_, bgl = m >> 6, s1 = m & 63, rip = n >> 6, k2 = n & 63;
              f16* d = z + ((size_t)(k2 * 2048 + bgl) * 128 + rip * 64 + s1);
              constexpr size_t ks = 2048ull * 128;
              d[0] = (f16)v0; d[ks] = (f16)v1; d[2 * ks] = (f16)v2; d[3 * ks] = (f16)v3;
            });
}

DI void ctxdft_tile(KP P, char* smem, int tile) {
  const int nt = tile & 1, mt = tile >> 1;
  char* b2 = (char*)P->out;
  const f16* w1c = (const f16*)(b2 + B2_W1C);
  const f16* dm = (const f16*)(P->ws + WS_D256);
  f16* yc = (f16*)(P->ws + WS_H);
  gemm_tile<true>(smem, 512, [&](int r) { return w1c + (size_t)(mt * 256 + r) * 512; },
            [&](int r) { return dm + (size_t)(nt * 128 + r) * 512; },
            [&](int m_, int n_, float v0, float v1, float v2, float v3) {
              const int m = mt * 256 + m_, k = nt * 128 + n_, b = m >> 9, g = (m >> 7) & 3, l = m & 127;
              f16* d = yc + (size_t)(b * 256 + k) * 1024 + 512 + g * 128 + l;
              d[0] = (f16)v0; d[1024] = (f16)v1; d[2048] = (f16)v2; d[3072] = (f16)v3;
            });
}

DI void ct2_tile(KP P, char* smem, int tile) {
  const int k2 = tile >> 3, mt = tile & 7;
  char* b2 = (char*)P->out;
  const f16* z = (const f16*)(b2 + B2_Z);
  const f16* dsm = (const f16*)(P->ws + WS_DS);
  f16* yc = (f16*)(P->ws + WS_H);
  gemm_tile<true>(smem, 128, [&](int r) { return z + (size_t)(k2 * 2048 + mt * 256 + r) * 128; },
            [&](int r) { return dsm + (size_t)(64 * (r & 63) + k2) * 128; },
            [&](int m_, int n, float v0, float v1, float v2, float v3) {
              if (n < 64) {
                const int m = mt * 256 + m_, b = m >> 9, g = (m >> 7) & 3, l = m & 127, k = 64 * n + k2;
                f16* d = yc + (size_t)(TP + b * 4096 + k) * 1024 + 512 + g * 128 + l;
                constexpr size_t ks = 64ull * 1024;
                d[0] = (f16)v0; d[ks] = (f16)v1; d[2 * ks] = (f16)v2; d[3 * ks] = (f16)v3;
              }
            });
}

template <bool FROM_INPUT>
DI void phase_proj(KP P, char* smem, const f16* w, const float* bias_, int layer, int gate_idx) {
  const f16* a = (const f16*)(P->ws + WS_H);
  f16* xr = (f16*)(P->ws + WS_XR);
  auto epi_at = [&](int t, int col, float v0, float v1, float v2, float v3) {
    const int cond = cond_of(t);
    const float4 bias = *(const float4*)(bias_ + col);
    const float4 gt = *(const float4*)((const float*)(P->ws + WS_ADAF) + (layer * 5 + cond) * 6144 + gate_idx * 1024 + col);
    float4 x;
    if (FROM_INPUT) {
      x = *(const float4*)((t < TP ? P->x_prompt + (size_t)t * 1024 : P->x_sample + (size_t)(t - TP) * 1024) + col);
    } else {
      const f16x4 q = *(const f16x4*)(xr + (size_t)t * 1024 + col);
      x.x = (float)q[0]; x.y = (float)q[1]; x.z = (float)q[2]; x.w = (float)q[3];
    }
    return pack4h(ALPHA * x.x + gt.x * (v0 + bias.x), ALPHA * x.y + gt.y * (v1 + bias.y),
                  ALPHA * x.z + gt.z * (v2 + bias.z), ALPHA * x.w + gt.w * (v3 + bias.w));
  };
  auto full_tile = [&](int tm, int tn) {
    gemm8w_n128(smem, 1024, [&](int r) { return a + (size_t)(tm * 256 + r) * 1024; },
                [&](int r) { return w + (size_t)(tn * 128 + r) * 1024; },
                [&](int m, int n, float v0, float v1, float v2, float v3) { return epi_at(tm * 256 + m, tn * 128 + n, v0, v1, v2, v3); },
                [&](int m) { return xr + (size_t)(tm * 256 + m) * 1024 + tn * 128; });
  };
  if (gridDim.x == 256) {
    const int x = blockIdx.x & 7, li = blockIdx.x >> 3;
    for (int lt = li; lt < 64; lt += 32) full_tile(x + 8 * (lt >> 3), lt & 7);
    const int tm = x + 8 * (8 + (li >> 4)), tn = (li & 15) >> 1, r0 = tm * 256 + (li & 1) * 128;
    gemm8w_m128(smem, 1024, [&](int r) { return a + (size_t)(r0 + r) * 1024; }, [&](int r) { return w + (size_t)(tn * 128 + r) * 1024; },
                [&](int m, int n, float v0, float v1, float v2, float v3) { return epi_at(r0 + m, tn * 128 + n, v0, v1, v2, v3); },
                [&](int m) { return xr + (size_t)(r0 + m) * 1024 + tn * 128; });
  } else {
    for (TileIter ti(8); ti.valid(); ti.next()) full_tile(ti.tm(), ti.tn());
  }
}

DI void phase_mlp1(KP P, char* smem, int layer) {
  const f16* a = (const f16*)(P->ws + WS_H);
  const f16* w = (const f16*)(P->ws + WS_W1) + (size_t)layer * 4096 * 1024;
  const float* bias_ = P->b1 + layer * 4096;
  for (TileIter ti(16); ti.valid(); ti.next()) {
    const int tm = ti.tm(), tn = ti.tn();
    f16* hid = tm * 256 < TH ? (f16*)P->out + (size_t)(tm * 256) * 4096 : (f16*)(P->ws + WS_B1) + (size_t)(tm * 256 - TH) * 4096;
    gemm8w<256, true, true>(smem, 1024, [&](int r) { return a + (size_t)(tm * 256 + r) * 1024; },
              [&](int r) { return w + (size_t)(tn * 256 + r) * 1024; },
              [&](int m, int n, float v0, float v1, float v2, float v3) {
                const float4 bias = *(const float4*)(bias_ + tn * 256 + n);
                v0 = fmaxf(v0 + bias.x, 0.f); v1 = fmaxf(v1 + bias.y, 0.f); v2 = fmaxf(v2 + bias.z, 0.f); v3 = fmaxf(v3 + bias.w, 0.f);
                return pack4h(v0 * v0, v1 * v1, v2 * v2, v3 * v3);
              }, [&](int m) { return hid + (size_t)m * 4096 + tn * 256; });
  }
}

DI void phase_mlp2(KP P, char* smem, int layer) {
  const f16* w = (const f16*)(P->ws + WS_W2) + (size_t)layer * 1024 * 4096;
  const float* bias_ = P->b2 + layer * 1024;
  f16* xr = (f16*)(P->ws + WS_XR);
  auto epi_at = [&](int t, int col, float v0, float v1, float v2, float v3) {
    const int cond = cond_of(t);
    const float4 bias = *(const float4*)(bias_ + col);
    const float4 gt = *(const float4*)((const float*)(P->ws + WS_ADAF) + (layer * 5 + cond) * 6144 + 5 * 1024 + col);
    f16* d = xr + (size_t)t * 1024 + col;
    const f16x4 q = *(const f16x4*)d;
    return pack4h(ALPHA * (float)q[0] + gt.x * (v0 + bias.x), ALPHA * (float)q[1] + gt.y * (v1 + bias.y),
                  ALPHA * (float)q[2] + gt.z * (v2 + bias.z), ALPHA * (float)q[3] + gt.w * (v3 + bias.w));
  };
  auto hid_row = [&](int t) { return t < TH ? (const f16*)P->out + (size_t)t * 4096 : (const f16*)(P->ws + WS_B1) + (size_t)(t - TH) * 4096; };
  auto full_tile = [&](int tm, int tn) {
    const f16* hid = hid_row(tm * 256);
    gemm8w_n128(smem, 4096, [&](int r) { return hid + (size_t)r * 4096; }, [&](int r) { return w + (size_t)(tn * 128 + r) * 4096; },
                [&](int m, int n, float v0, float v1, float v2, float v3) { return epi_at(tm * 256 + m, tn * 128 + n, v0, v1, v2, v3); },
                [&](int m) { return xr + (size_t)(tm * 256 + m) * 1024 + tn * 128; });
  };
  if (gridDim.x == 256) {
    const int x = blockIdx.x & 7, li = blockIdx.x >> 3;
    for (int lt = li; lt < 64; lt += 32) full_tile(x + 8 * (lt >> 3), lt & 7);
    const int tm = x + 8 * (8 + (li >> 4)), tn = (li & 15) >> 1, r0 = tm * 256 + (li & 1) * 128;
    const f16* hid = hid_row(r0);
    gemm8w_m128(smem, 4096, [&](int r) { return hid + (size_t)r * 4096; }, [&](int r) { return w + (size_t)(tn * 128 + r) * 4096; },
                [&](int m, int n, float v0, float v1, float v2, float v3) { return epi_at(r0 + m, tn * 128 + n, v0, v1, v2, v3); },
                [&](int m) { return xr + (size_t)(r0 + m) * 1024 + tn * 128; });
  } else {
    for (TileIter ti(8); ti.valid(); ti.next()) full_tile(ti.tm(), ti.tn());
  }
}

DI void qkv_tile(KP P, char* smem, int tile) {
  const int tm = tile / 12, tn = tile % 12;
  const f16* a = (const f16*)(P->ws + WS_H);
  const f16* w = (const f16*)(P->ws + WS_WQKV);
  f16* qbuf = (f16*)(P->ws + WS_B1);
  f16* kbuf = qbuf + (size_t)T * 1024;
  char* b2 = (char*)P->out;
  if (tn < 8) {
    gemm8w<256, true, true>(smem, 1024, [&](int r) { return a + (size_t)(tm * 256 + r) * 1024; },
              [&](int r) { return w + (size_t)(tn * 256 + r) * 1024; },
              [&](int m, int n, float v0, float v1, float v2, float v3) {
                const int col = tn * 256 + n, t = tm * 256 + m;
                const float4 bias = *(const float4*)(P->o_b_qkv + col);
                v0 += bias.x; v1 += bias.y; v2 += bias.z; v3 += bias.w;
                if (col < 1024) return pack4h(v0 * QSCALE, v1 * QSCALE, v2 * QSCALE, v3 * QSCALE);
                const int cc = col - 1024;
                if (t < TP) {
                  const int b = t >> 8, s = t & 255, hd = cc >> 6, dd = cc & 63;
                  float4 o; o.x = v0; o.y = v1; o.z = v2; o.w = v3;
                  *(float4*)(P->out + OUT_NK + ((size_t)((b * 16 + hd) * 256 + s) * 64 + dd)) = o;
                }
                return pack4h(v0, v1, v2, v3);
              }, [&](int m) { return (tn < 4 ? qbuf + tn * 256 : kbuf + (tn - 4) * 256) + (size_t)(tm * 256 + m) * 1024; });
  } else {
    gemm8w<256, false>(smem, 1024, [&](int r) { return a + (size_t)(tm * 256 + r) * 1024; },
              [&](int r) { return w + (size_t)(tn * 256 + r) * 1024; },
              [&](int m, int n, float v0, float v1, float v2, float v3) {
                const int col = tn * 256 + n, t = tm * 256 + m;
                const float bias = P->o_b_qkv[col];
                v0 += bias; v1 += bias; v2 += bias; v3 += bias;
                const int cc = col - 2048, hd = cc >> 6, dd = cc & 63;
                if (t < TP) {
                  const int b = t >> 8, s = t & 255;
                  store4h((f16*)(b2 + B2_VTC) + ((size_t)((b * 16 + hd) * 64 + dd) * 256 + s), v0, v1, v2, v3);
                  float* o = P->out + OUT_NV + ((size_t)((b * 16 + hd) * 256 + s) * 64 + dd);
                  o[0] = v0; o[64] = v1; o[128] = v2; o[192] = v3;
                } else {
                  const int lt = t - TP, b = lt >> 12, s = lt & 4095;
                  store4h((f16*)(b2 + B2_VTL) + ((size_t)((b * 16 + hd) * 64 + dd) * 4096 + s), v0, v1, v2, v3);
                }
              });
  }
}

DI void phase_qkv(KP P, char* smem) {
  constexpr int NG = 80 * 12, NCK = 256, NCV = 512;
  char* b2 = (char*)P->out;
  for (TileIter ti(12); ti.valid(); ti.next()) qkv_tile(P, smem, ti.tm() * 12 + ti.tn());
  char* hsm = smem + half_() * kHalfLds;
  int it0 = blockIdx.x * 2 + half_(), itstep = gridDim.x * 2;
  if (gridDim.x == 256) {
    const int li = blockIdx.x >> 3;
    if (li >= 24) { it0 = (((li - 24) * 8 + (blockIdx.x & 7)) * 2) + half_(); itstep = 128; } else { it0 = NCK + NCV; }
  }
  for (int it = it0; it < NCK + NCV; it += itstep) {
    if (it < NCK) {
      const int i0 = it * 8192;
      f16* ck = (f16*)(b2 + B2_CK);
#pragma unroll
      for (int j = 0; j < 8; ++j) {
        const int e = i0 + (j * 256 + tid_()) * 4;
        const float4 v = *(const float4*)(P->cache_k + e);
        store4h(ck + e, v.x, v.y, v.z, v.w);
      }
    } else {
      const int i = it - NCK, bh = i >> 3, kt = i & 7;
      tconv_tile(hsm, P->cache_v + (size_t)bh * 512 * 64, 64, (f16*)(b2 + B2_CVT) + (size_t)bh * 64 * 512, 512, kt * 64, 0);
    }
  }
}

#define XB_TMO      128
#define XB_XCNT(j)  (256  + 64 * (j))
#define XB_XSUB(j)  (1280 + 64 * (j))
#define XB_XGEN(j)  (2304 + 64 * (j))
#define XB_TOP      3328
#define XB_TOPGEN   3392
#define XCD_BAR_WORDS 3456
#define XB_SPIN_CAP (1u << 18)
DI unsigned xb_ld(unsigned* p) { return __hip_atomic_load(p, __ATOMIC_RELAXED, __HIP_MEMORY_SCOPE_AGENT); }
DI unsigned xb_add(unsigned* p, unsigned v) { return __hip_atomic_fetch_add(p, v, __ATOMIC_RELAXED, __HIP_MEMORY_SCOPE_AGENT); }
DI unsigned xb_xcc_id() { return (unsigned)__builtin_amdgcn_s_getreg((3 << 11) | 20) & 0xFu; }
#define XB_SPIN(cond, bar) do { unsigned _sp = 0; while (cond) { __builtin_amdgcn_s_sleep(1); \
    if ((++_sp & 255u) == 0u) { if (xb_ld(&(bar)[XB_TMO])) break; if (_sp > XB_SPIN_CAP) { atomicAdd(&(bar)[XB_TMO], 1u); break; } } } } while (0)
struct XcdBarrier { unsigned* bar; unsigned x; volatile LAS unsigned* st; };
DI XcdBarrier xcd_barrier_post(unsigned* bar, volatile LAS unsigned* st) {
  XcdBarrier b; b.bar = bar; b.x = xb_xcc_id(); b.st = st;
  if (threadIdx.x == 0) (void)xb_add(&bar[XB_XCNT(b.x)], 1u);
  return b;
}
DI void xcd_barrier_complete(unsigned* bar, unsigned x, unsigned& nloc, unsigned& nx) {
  const unsigned G = gridDim.x * gridDim.y * gridDim.z;
  unsigned sum, cnt, mine, sp = 0u;
  for (;;) {
    sum = 0u; cnt = 0u; mine = 0u;
#pragma unroll
    for (unsigned j = 0; j < 16; ++j) { const unsigned c = xb_ld(&bar[XB_XCNT(j)]); sum += c; cnt += (c > 0u) ? 1u : 0u; mine = (j == x) ? c : mine; }
    if (sum == G) break;
    __builtin_amdgcn_s_sleep(1);
    if ((++sp & 255u) == 0u) { if (xb_ld(&bar[XB_TMO])) break; if (sp > XB_SPIN_CAP) { atomicAdd(&bar[XB_TMO], 1u); break; } }
  }
  nloc = mine > 0u ? mine : 1u; nx = cnt > 0u ? cnt : 1u;
}
DI void xcd_barrier(const XcdBarrier& b) {
  asm volatile("s_waitcnt vmcnt(0)" ::: "memory");
  __syncthreads();
  if (threadIdx.x == 0) {
    unsigned* bar = b.bar;
    __builtin_amdgcn_s_waitcnt(0);
    unsigned nloc = b.st[0], nx = b.st[1];
    if (nloc == 0u) { xcd_barrier_complete(bar, b.x, nloc, nx); b.st[0] = nloc; b.st[1] = nx; }
    const unsigned old = xb_add(&bar[XB_XSUB(b.x)], 1u);
    const unsigned gen = old / nloc;
    if (old + 1u == (gen + 1u) * nloc) {
      __builtin_amdgcn_fence(__ATOMIC_RELEASE, "agent");
      asm volatile("s_waitcnt vmcnt(0)" ::: "memory");
      const unsigned og = xb_add(&bar[XB_TOP], 1u);
      const unsigned tg = og / nx;
      if (og + 1u == (tg + 1u) * nx) xb_add(&bar[XB_TOPGEN], 1u);
      else XB_SPIN(xb_ld(&bar[XB_TOPGEN]) == tg, bar);
      __builtin_amdgcn_fence(__ATOMIC_ACQUIRE, "agent");
      xb_add(&bar[XB_XGEN(b.x)], 1u);
      asm volatile("s_waitcnt vmcnt(0)" ::: "memory");
    } else {
      XB_SPIN(xb_ld(&bar[XB_XGEN(b.x)]) == gen, bar);
      __builtin_amdgcn_fence(__ATOMIC_ACQUIRE, "agent");
      asm volatile("s_waitcnt vmcnt(0)" ::: "memory");
    }
  }
  __syncthreads();
}

enum { PH_PREP = 0, PH_LN0, PH_GIN, PH_SCAN0, PH_SCAN1, PH_CT2, PH_OUT0, PH_LN1, PH_MLP1A, PH_MLP2A, PH_LN2, PH_QKV, PH_ATT,
       PH_OUT1, PH_LN3, PH_MLP1B, PH_MLP2B, PH_LN4, NPH };

__global__ void __launch_bounds__(512, 2) mk(Params PP) {
  extern __shared__ __attribute__((aligned(16))) char smem[];
  cg::grid_group grid = cg::this_grid();
  __shared__ uint4 xb_words;
  if (threadIdx.x == 0) xb_words = make_uint4(0u, 0u, 0u, 0u);
  __syncthreads();
  const XcdBarrier xb = xcd_barrier_post((unsigned*)(PP.ws + WS_BAR), (volatile LAS unsigned*)&xb_words);
  const int phase_hi = PP.phase_hi;
  if (phase_hi > 1000) grid.sync();
  for (int ph = PP.phase_lo; ph < phase_hi; ++ph) {
   const int reps = (ph == REP_PHASE) ? 2 : 1;
   for (int rep = 0; rep < reps; ++rep) {
    KP P = (KP)__builtin_amdgcn_kernarg_segment_ptr();
    asm volatile("" : "+s"(P));
    switch (ph) {
      case PH_PREP: phase_prep(P, smem); break;
      case PH_LN0: phase_ln<true, false, true, false>(P, nullptr, nullptr, 0, 0, 1); break;
      case PH_GIN: phase_gin(P, smem); break;
      case PH_SCAN0:
        for (int it = blockIdx.x * 2 + half_(); it < 2560 + 640; it += gridDim.x * 2) {
          char* hsm = smem + half_() * kHalfLds;
          if (it < 2560) scan_item(P, hsm, it, 0); else g1_tile(P, hsm, it - 2560);
        }
        break;
      case PH_SCAN1:
        for (int it = blockIdx.x * 2 + half_(); it < 64 + 2560 + 512; it += gridDim.x * 2) {
          char* hsm = smem + half_() * kHalfLds;
          if (it < 64) ctxdft_tile(P, hsm, it);
          else if (it < 64 + 2560) scan_item(P, hsm, it - 64, 1);
          else ct1_tile(P, hsm, it - 64 - 2560);
        }
        break;
      case PH_CT2:
        for (int it = blockIdx.x * 2 + half_(); it < 512; it += gridDim.x * 2) ct2_tile(P, smem + half_() * kHalfLds, it);
        break;
      case PH_OUT0: phase_proj<true>(P, smem, (const f16*)(P->ws + WS_WOUT0), P->e_b_out, 0, 2); break;
      case PH_LN1: phase_ln<false, true, true, false>(P, P->ln1_g, P->ln1_b, 0, 3, 4); break;
      case PH_MLP1A: phase_mlp1(P, smem, 0); break;
      case PH_MLP2A: phase_mlp2(P, smem, 0); break;
      case PH_LN2: phase_ln<false, true, true, false>(P, P->ln2_g, P->ln2_b, 1, 0, 1); break;
      case PH_QKV: phase_qkv(P, smem); break;
      case PH_ATT:
        for (int it = blockIdx.x; it < 1280; it += gridDim.x) {
          int item = it;
          if (it < 1024 && gridDim.x == 256) {
            const int x = blockIdx.x & 7, li = blockIdx.x >> 3, r = it >> 8;
            item = (r * 16 + 2 * x + (li >> 4)) * 16 + (li & 15);
          }
          attn_item(P, smem, item);
        }
        break;
      case PH_OUT1: phase_proj<false>(P, smem, (const f16*)(P->ws + WS_WO1), P->o_b_out, 1, 2); break;
      case PH_LN3: phase_ln<false, true, true, false>(P, P->ln1_g + 1024, P->ln1_b + 1024, 1, 3, 4); break;
      case PH_MLP1B: phase_mlp1(P, smem, 1); break;
      case PH_MLP2B: phase_mlp2(P, smem, 1); break;
      case PH_LN4: phase_ln<false, true, false, true>(P, P->ln2_g + 1024, P->ln2_b + 1024, 1, 0, 0); break;
    }
    if (ph + 1 < phase_hi || rep + 1 < reps) xcd_barrier(xb);
   }
  }
}

extern "C" void kernel_launch(void* const* d_in, const int* in_sizes, int n_in, void* d_out, int out_size, void* d_ws,
                              size_t ws_size, hipStream_t stream) {
  static int grid_blocks = 0;
  if (!grid_blocks) {
    hipFuncSetAttribute((const void*)mk, hipFuncAttributeMaxDynamicSharedMemorySize, kLds);
    int dev = 0, cus = 0, per_cu = 0;
    hipGetDevice(&dev);
    hipDeviceGetAttribute(&cus, hipDeviceAttributeMultiprocessorCount, dev);
    hipOccupancyMaxActiveBlocksPerMultiprocessor(&per_cu, mk, 512, kLds);
    if (per_cu > 1) per_cu = 1;
    grid_blocks = cus * per_cu;
  }
  Params p{};
  const float** pp = (const float**)&p;
  for (int i = 0; i < 33; ++i) pp[i] = (const float*)d_in[i];
  p.out = (float*)d_out;
  p.ws = (char*)d_ws;
  p.phase_lo = 0;
  p.phase_hi = NPH;
  if (ws_size < WS_END) { fprintf(stderr, "workspace too small: %zu < %zu\n", ws_size, (size_t)WS_END); return; }
  hipMemsetAsync((char*)d_ws + WS_BAR, 0, XCD_BAR_WORDS * 4, stream);
  void* args[] = {&p};
  hipError_t e = hipLaunchCooperativeKernel((const void*)mk, dim3(grid_blocks), dim3(512), args, kLds, stream);
  if (e != hipSuccess) fprintf(stderr, "cooperative launch failed: %s (grid %d)\n", hipGetErrorString(e), grid_blocks);
}
```

```cpp
#include <hip/hip_runtime.h>
#include <hip/hip_cooperative_groups.h>
#include <cstdio>
namespace cg = cooperative_groups;

typedef _Float16 f16;
typedef __attribute__((ext_vector_type(8))) _Float16 f16x8;
typedef __attribute__((ext_vector_type(4))) _Float16 f16x4;
typedef __attribute__((ext_vector_type(16))) float f32x16;
#define DI __device__ __forceinline__
#define LAS __attribute__((address_space(3)))
#define MFMA(a, b, c) __builtin_amdgcn_mfma_f32_32x32x16_f16((a), (b), (c), 0, 0, 0)

constexpr int T = 20480;
constexpr int TP = 4096;
constexpr int TH = 10240;
constexpr float ALPHA = 1.41421356237f;
constexpr float LOG2E = 1.4426950408889634f;
constexpr float QSCALE = 0.125f * LOG2E;
constexpr int kLds = 147456;
#define REP_PHASE -1

constexpr size_t WS_WIN = 0;
constexpr size_t WS_WOUT0 = WS_WIN + 1536ull * 1024 * 2;
constexpr size_t WS_W1 = WS_WOUT0 + 1024ull * 1024 * 2;
constexpr size_t WS_W2 = WS_W1 + 2ull * 4096 * 1024 * 2;
constexpr size_t WS_WQKV = WS_W2 + 2ull * 4096 * 1024 * 2;
constexpr size_t WS_WO1 = WS_WQKV + 3072ull * 1024 * 2;
constexpr size_t WS_GW = WS_WO1 + 1024ull * 1024 * 2;
constexpr size_t WS_FC = WS_GW + 32ull * 4096 * 2;
constexpr size_t WS_D256 = WS_FC + 256ull * 128 * 2;
constexpr size_t WS_F64 = WS_D256 + 256ull * 512 * 2;
constexpr size_t WS_DS = WS_F64 + 128ull * 128 * 2;
constexpr size_t WS_ADAP = WS_DS + 4096ull * 128 * 2;
constexpr size_t WS_SUM = WS_ADAP + 2ull * 4 * 5 * 6144 * 4;
constexpr size_t WS_XR = WS_SUM + 320ull * 2 * 512 * 8;
constexpr size_t WS_H = WS_XR + (size_t)T * 1024 * 4;
constexpr size_t WS_B1 = WS_H + (size_t)T * 1024 * 2;
constexpr size_t WS_BAR = WS_B1 + (size_t)T * 1024 * 4;
constexpr size_t WS_ADAF = WS_BAR + 3456 * 4;
constexpr size_t WS_END = WS_ADAF + 2ull * 5 * 6144 * 4;
constexpr size_t B2_W1C = 0;
constexpr size_t B2_W1L = 8388608;
constexpr size_t B2_Z = 41943040;
constexpr size_t B2_VTC = 0;
constexpr size_t B2_VTL = 8388608;
constexpr size_t B2_CK = 41943040;
constexpr size_t B2_CVT = 46137344;
constexpr size_t OUT_LRU = (size_t)T * 1024;
constexpr size_t OUT_NK = OUT_LRU + 16 * 2 * 512;
constexpr size_t OUT_NV = OUT_NK + 16ull * 16 * 256 * 64;

struct Params {
  const float *x_prompt, *x_sample, *c, *state_lru, *cache_k, *cache_v, *c_ctx, *ada_w, *ada_b, *ln1_g, *ln1_b, *ln2_g,
      *ln2_b, *w1, *b1, *w2, *b2, *e_w_in, *e_b_in, *e_conv_w, *e_conv_b, *e_w_r, *e_b_r, *e_w_i, *e_b_i, *e_lam,
      *e_w_out, *e_b_out, *o_w_qkv, *o_b_qkv, *o_rpb, *o_w_out, *o_b_out;
  float* out;
  char* ws;
  int phase_lo, phase_hi;
};

typedef const __attribute__((address_space(4))) Params* KP;
DI int tidf_() { int t = threadIdx.x; asm volatile("" : "+v"(t)); return t; }
DI int tid_() { return tidf_() & 255; }
DI int half_() { return __builtin_amdgcn_readfirstlane((int)(threadIdx.x >> 8)); }
constexpr int kHalfLds = 73728;
DI int crow(int reg, int hh) { return (reg & 3) + 8 * (reg >> 2) + 4 * hh; }
DI float wave_sum(float v) {
#pragma unroll
  for (int o = 32; o; o >>= 1) v += __shfl_xor(v, o);
  return v;
}
DI float sigmoidf_(float x) { return __builtin_amdgcn_rcpf(1.f + __expf(-x)); }
DI float one_minus_exp(float x) {
  const float p = -x * (1.f + x * (0.5f + x * (0.16666667f + x * (0.041666668f + x * (0.0083333338f + x * 0.0013888889f)))));
  return x > -0.25f ? p : 1.f - __expf(x);
}
DI float ada_val(KP P, int layer, int cond, int idx) {
  const float* adap = (const float*)(P->ws + WS_ADAP);
  float s = P->ada_b[layer * 6144 + idx];
#pragma unroll
  for (int kc = 0; kc < 4; ++kc) s += adap[((layer * 4 + kc) * 5 + cond) * 6144 + idx];
  return s;
}
DI float adaf(KP P, int layer, int cond, int idx) { return ((const float*)(P->ws + WS_ADAF))[(layer * 5 + cond) * 6144 + idx]; }
DI int cond_of(int t) { return t < TP ? 0 : 1 + ((t - TP) >> 12); }

template <bool TR = false, int VAR = 0, class AF, class BF, class EF>
DI void gemm_tile(char* smem, int K, AF arow, BF brow, EF epi) {
  const int tid = tid_(), lane = tid & 63, wave = tid >> 6;
  const int wm = wave >> 1, wn = wave & 1, l32 = lane & 31, hh = lane >> 5;
  const int lr = lane >> 2, lc = ((lane & 3) ^ ((lane >> 4) & 3)) * 8;
  const f16* ap0 = arow(wave * 64 + lr) + lc;
  const f16* ap1 = arow(wave * 64 + 16 + lr) + lc;
  const f16* ap2 = arow(wave * 64 + 32 + lr) + lc;
  const f16* ap3 = arow(wave * 64 + 48 + lr) + lc;
  const f16* bp0 = brow(wave * 32 + lr) + lc;
  const f16* bp1 = brow(wave * 32 + 16 + lr) + lc;
  const int dA = wave * 4096 + lane * 16, dB = 16384 + wave * 2048 + lane * 16;
#define DMA(stage_off, ko)                                                                                       \
  __builtin_amdgcn_global_load_lds((const void*)(ap0 + (ko)), (LAS void*)(smem + (stage_off) + dA), 16, 0, 0);          \
  __builtin_amdgcn_global_load_lds((const void*)(ap1 + (ko)), (LAS void*)(smem + (stage_off) + dA + 1024), 16, 0, 0);   \
  __builtin_amdgcn_global_load_lds((const void*)(ap2 + (ko)), (LAS void*)(smem + (stage_off) + dA + 2048), 16, 0, 0);   \
  __builtin_amdgcn_global_load_lds((const void*)(ap3 + (ko)), (LAS void*)(smem + (stage_off) + dA + 3072), 16, 0, 0);   \
  __builtin_amdgcn_global_load_lds((const void*)(bp0 + (ko)), (LAS void*)(smem + (stage_off) + dB), 16, 0, 0);          \
  __builtin_amdgcn_global_load_lds((const void*)(bp1 + (ko)), (LAS void*)(smem + (stage_off) + dB + 1024), 16, 0, 0);
  const int nk = K >> 5;
  DMA(0, 0)
  DMA(24576, 32)
  asm volatile("s_waitcnt vmcnt(6)" ::: "memory");
  __builtin_amdgcn_s_barrier();
  f32x16 acc[4][2];
#pragma unroll
  for (int i = 0; i < 4; ++i)
#pragma unroll
    for (int j = 0; j < 2; ++j)
#pragma unroll
      for (int e = 0; e < 16; ++e) acc[i][j][e] = 0.f;
  const int rsw = (l32 >> 2) & 3;
  const int aoff = (wm * 128 + l32) * 64, boff = 16384 + (wn * 64 + l32) * 64;
  int cur = 0, nxt = 49152;
  for (int kt = 0; kt < nk; ++kt) {
    if (kt + 2 < nk) { const int kk = kt + 2; DMA(nxt, (VAR == 1 ? 0 : VAR == 3 ? ((((kk >> 1) ^ lr) << 6) + (kk & 1) * 32) : kk * 32)) }
    const char* st = smem + cur;
    {
      const int co0 = ((0 + hh) ^ rsw) << 4, co1 = ((2 + hh) ^ rsw) << 4;
      f16x8 a0[4], b0[2], a1[4], b1[2];
#pragma unroll
      for (int j = 0; j < 2; ++j) b0[j] = *(const f16x8*)(st + boff + j * 2048 + co0);
#pragma unroll
      for (int i = 0; i < 4; ++i) a0[i] = *(const f16x8*)(st + aoff + i * 2048 + co0);
#pragma unroll
      for (int j = 0; j < 2; ++j) b1[j] = *(const f16x8*)(st + boff + j * 2048 + co1);
#pragma unroll
      for (int i = 0; i < 4; ++i) a1[i] = *(const f16x8*)(st + aoff + i * 2048 + co1);
      __builtin_amdgcn_sched_barrier(0);
      if (VAR == 2) { acc[0][0][0] += (float)a0[0][0] + (float)b0[0][0] + (float)a1[3][0] + (float)b1[1][0]; } else {
#pragma unroll
      for (int i = 0; i < 4; ++i)
#pragma unroll
        for (int j = 0; j < 2; ++j) acc[i][j] = TR ? MFMA(b0[j], a0[i], acc[i][j]) : MFMA(a0[i], b0[j], acc[i][j]);
#pragma unroll
      for (int i = 0; i < 4; ++i)
#pragma unroll
        for (int j = 0; j < 2; ++j) acc[i][j] = TR ? MFMA(b1[j], a1[i], acc[i][j]) : MFMA(a1[i], b1[j], acc[i][j]);
      }
      __builtin_amdgcn_sched_barrier(0);
    }
    if (kt + 2 < nk) asm volatile("s_waitcnt vmcnt(6)" ::: "memory");
    else asm volatile("s_waitcnt vmcnt(0)" ::: "memory");
    __builtin_amdgcn_s_barrier();
    cur = cur == 49152 ? 0 : cur + 24576;
    nxt = nxt == 49152 ? 0 : nxt + 24576;
  }
#undef DMA
#pragma unroll
  for (int i = 0; i < 4; ++i)
#pragma unroll
    for (int j = 0; j < 2; ++j)
#pragma unroll
      for (int q = 0; q < 4; ++q)
        if (TR) epi(wm * 128 + i * 32 + l32, wn * 64 + j * 32 + 8 * q + 4 * hh, acc[i][j][4 * q], acc[i][j][4 * q + 1], acc[i][j][4 * q + 2], acc[i][j][4 * q + 3]);
        else epi(wm * 128 + i * 32 + 8 * q + 4 * hh, wn * 64 + j * 32 + l32, acc[i][j][4 * q], acc[i][j][4 * q + 1], acc[i][j][4 * q + 2], acc[i][j][4 * q + 3]);
}

template <int BN, bool TR, bool PK = false, class AF, class BF, class EF, class RF = int>
DI void gemm8w(char* smem, int K, AF arow, BF brow, EF epi, RF rowptr = 0) {
  constexpr int WN = BN / 64, WM = 8 / WN, MI = 256 / (WM * 32), NB = BN / 128;
  constexpr int STG = 16384 + BN * 64;
  const int tid = tidf_(), lane = tid & 63, wave = tid >> 6;
  const int grp = __builtin_amdgcn_readfirstlane(wave >> 2);
  const int wm = wave / WN, wn = wave % WN, l32 = lane & 31, hh = lane >> 5;
  const int lr = lane >> 2, lc = ((lane & 3) ^ ((lane >> 4) & 3)) * 8;
  const f16* ap0 = arow(wave * 32 + lr) + lc;
  const f16* ap1 = arow(wave * 32 + 16 + lr) + lc;
  const f16* bp0 = brow(wave * (16 * NB) + lr) + lc;
  const f16* bp1 = NB == 2 ? brow(wave * 32 + 16 + lr) + lc : bp0;
  const int dA = wave * 2048 + lane * 16, dB = 16384 + wave * (1024 * NB) + lane * 16;
#define DMA4(stage_off, ko)                                                                                              \
  __builtin_amdgcn_global_load_lds((const void*)(ap0 + (ko)), (LAS void*)(smem + (stage_off) + dA), 16, 0, 0);          \
  __builtin_amdgcn_global_load_lds((const void*)(ap1 + (ko)), (LAS void*)(smem + (stage_off) + dA + 1024), 16, 0, 0);   \
  __builtin_amdgcn_global_load_lds((const void*)(bp0 + (ko)), (LAS void*)(smem + (stage_off) + dB), 16, 0, 0);          \
  if (NB == 2) __builtin_amdgcn_global_load_lds((const void*)(bp1 + (ko)), (LAS void*)(smem + (stage_off) + dB + 1024), 16, 0, 0);
  const int nk = K >> 5;
  DMA4(0, 0)
  DMA4(STG, 32)
  DMA4(2 * STG, 64)
  if (NB == 2) asm volatile("s_waitcnt vmcnt(8)" ::: "memory"); else asm volatile("s_waitcnt vmcnt(6)" ::: "memory");
  __builtin_amdgcn_s_barrier();
  if (grp == 1) __builtin_amdgcn_s_barrier();
  f32x16 acc[MI][2];
#pragma unroll
  for (int i = 0; i < MI; ++i)
#pragma unroll
    for (int j = 0; j < 2; ++j)
#pragma unroll
      for (int e = 0; e < 16; ++e) acc[i][j][e] = 0.f;
  const int rsw = (l32 >> 2) & 3;
  const int aoff = (wm * (MI * 32) + l32) * 64, boff = 16384 + (wn * 64 + l32) * 64;
  const int co0 = ((0 + hh) ^ rsw) << 4, co1 = ((2 + hh) ^ rsw) << 4;
  int cur = 0, nxt = 3 * STG;
  for (int kt = 0; kt < nk; ++kt) {
    const char* st = smem + cur;
    f16x8 a0[MI], b0[2], a1[MI], b1[2];
#pragma unroll
    for (int j = 0; j < 2; ++j) b0[j] = *(const f16x8*)(st + boff + j * 2048 + co0);
#pragma unroll
    for (int i = 0; i < MI; ++i) a0[i] = *(const f16x8*)(st + aoff + i * 2048 + co0);
#pragma unroll
    for (int j = 0; j < 2; ++j) b1[j] = *(const f16x8*)(st + boff + j * 2048 + co1);
#pragma unroll
    for (int i = 0; i < MI; ++i) a1[i] = *(const f16x8*)(st + aoff + i * 2048 + co1);
    __builtin_amdgcn_sched_barrier(0);
    if (kt + 2 < nk) {
      if (NB == 2) asm volatile("s_waitcnt vmcnt(4) lgkmcnt(0)" ::: "memory"); else asm volatile("s_waitcnt vmcnt(3) lgkmcnt(0)" ::: "memory");
    } else {
      asm volatile("s_waitcnt vmcnt(0) lgkmcnt(0)" ::: "memory");
    }
    __builtin_amdgcn_s_barrier();
    __builtin_amdgcn_sched_barrier(0);
#pragma unroll
    for (int i = 0; i < MI; ++i)
#pragma unroll
      for (int j = 0; j < 2; ++j) acc[i][j] = TR ? MFMA(b0[j], a0[i], acc[i][j]) : MFMA(a0[i], b0[j], acc[i][j]);
    __builtin_amdgcn_sched_barrier(0);
    if (kt + 3 < nk) { DMA4(nxt, (kt + 3) * 32) }
    __builtin_amdgcn_sched_barrier(0);
#pragma unroll
    for (int i = 0; i < MI; ++i)
#pragma unroll
      for (int j = 0; j < 2; ++j) acc[i][j] = TR ? MFMA(b1[j], a1[i], acc[i][j]) : MFMA(a1[i], b1[j], acc[i][j]);
    __builtin_amdgcn_sched_barrier(0);
    __builtin_amdgcn_s_barrier();
    __builtin_amdgcn_sched_barrier(0);
    cur = cur == 3 * STG ? 0 : cur + STG;
    nxt = nxt == 3 * STG ? 0 : nxt + STG;
  }
  if (grp == 0) __builtin_amdgcn_s_barrier();
#undef DMA4
  if constexpr (PK) {
#pragma unroll
    for (int i = 0; i < MI; ++i)
#pragma unroll
      for (int j = 0; j < 2; ++j)
#pragma unroll
        for (int q = 0; q < 4; q += 2) {
          const int m = wm * (MI * 32) + i * 32 + l32, n = wn * 64 + j * 32 + 8 * q;
          const uint2 pa = epi(m, n + 4 * hh, acc[i][j][4 * q], acc[i][j][4 * q + 1], acc[i][j][4 * q + 2], acc[i][j][4 * q + 3]);
          const uint2 pb = epi(m, n + 8 + 4 * hh, acc[i][j][4 * q + 4], acc[i][j][4 * q + 5], acc[i][j][4 * q + 6], acc[i][j][4 * q + 7]);
          store_pair16(rowptr(m) + n, pa, pb, hh);
        }
  } else
#pragma unroll
  for (int i = 0; i < MI; ++i)
#pragma unroll
    for (int j = 0; j < 2; ++j)
#pragma unroll
      for (int q = 0; q < 4; ++q)
        if (TR) epi(wm * (MI * 32) + i * 32 + l32, wn * 64 + j * 32 + 8 * q + 4 * hh, acc[i][j][4 * q], acc[i][j][4 * q + 1], acc[i][j][4 * q + 2], acc[i][j][4 * q + 3]);
        else epi(wm * (MI * 32) + i * 32 + 8 * q + 4 * hh, wn * 64 + j * 32 + l32, acc[i][j][4 * q], acc[i][j][4 * q + 1], acc[i][j][4 * q + 2], acc[i][j][4 * q + 3]);
}

template <class AF, class BF, class EF, class RF>
DI void gemm8w_n128(char* smem, int K, AF arow, BF brow, EF epi, RF rowptr) {
  constexpr int STG = 24576;
  const int tid = tidf_(), lane = tid & 63, wave = tid >> 6;
  const int grp = __builtin_amdgcn_readfirstlane(wave >> 2);
  const int wm = wave >> 1, wn = wave & 1, l32 = lane & 31, hh = lane >> 5;
  const int lr = lane >> 2, lc = ((lane & 3) ^ ((lane >> 4) & 3)) * 8;
  const f16* ap0 = arow(wave * 32 + lr) + lc;
  const f16* ap1 = arow(wave * 32 + 16 + lr) + lc;
  const f16* bp0 = brow(wave * 16 + lr) + lc;
  const int dA = wave * 2048 + lane * 16, dB = 16384 + wave * 1024 + lane * 16;
#define DMA3(stage_off, ko)                                                                                              \
  __builtin_amdgcn_global_load_lds((const void*)(ap0 + (ko)), (LAS void*)(smem + (stage_off) + dA), 16, 0, 0);          \
  __builtin_amdgcn_global_load_lds((const void*)(ap1 + (ko)), (LAS void*)(smem + (stage_off) + dA + 1024), 16, 0, 0);   \
  __builtin_amdgcn_global_load_lds((const void*)(bp0 + (ko)), (LAS void*)(smem + (stage_off) + dB), 16, 0, 0);
  const int nk = K >> 5;
  DMA3(0, 0)
  DMA3(STG, 32)
  DMA3(2 * STG, 64)
  DMA3(3 * STG, 96)
  asm volatile("s_waitcnt vmcnt(6)" ::: "memory");
  __builtin_amdgcn_s_barrier();
  if (grp == 1) __builtin_amdgcn_s_barrier();
  f32x16 acc[2][2];
#pragma unroll
  for (int i = 0; i < 2; ++i)
#pragma unroll
    for (int j = 0; j < 2; ++j)
#pragma unroll
      for (int e = 0; e < 16; ++e) acc[i][j][e] = 0.f;
  const int rsw = (l32 >> 2) & 3;
  const int aoff = (wm * 64 + l32) * 64, boff = 16384 + (wn * 64 + l32) * 64;
  const int co0 = ((0 + hh) ^ rsw) << 4, co1 = ((2 + hh) ^ rsw) << 4;
  int cur = 0, nxt = 4 * STG;
  for (int kt = 0; kt < nk; kt += 2) {
    const char* st = smem + cur;
    f16x8 a0[2], b0[2], a1[2], b1[2], a2[2], b2[2], a3[2], b3[2];
#pragma unroll
    for (int j = 0; j < 2; ++j) { b0[j] = *(const f16x8*)(st + boff + j * 2048 + co0); b1[j] = *(const f16x8*)(st + boff + j * 2048 + co1); }
#pragma unroll
    for (int i = 0; i < 2; ++i) { a0[i] = *(const f16x8*)(st + aoff + i * 2048 + co0); a1[i] = *(const f16x8*)(st + aoff + i * 2048 + co1); }
#pragma unroll
    for (int j = 0; j < 2; ++j) { b2[j] = *(const f16x8*)(st + STG + boff + j * 2048 + co0); b3[j] = *(const f16x8*)(st + STG + boff + j * 2048 + co1); }
#pragma unroll
    for (int i = 0; i < 2; ++i) { a2[i] = *(const f16x8*)(st + STG + aoff + i * 2048 + co0); a3[i] = *(const f16x8*)(st + STG + aoff + i * 2048 + co1); }
    __builtin_amdgcn_sched_barrier(0);
    if (kt + 4 < nk) { DMA3(nxt, (kt + 4) * 32) DMA3(nxt + STG, (kt + 5) * 32) }
    __builtin_amdgcn_sched_barrier(0);
    if (kt + 4 < nk) asm volatile("s_waitcnt vmcnt(6) lgkmcnt(0)" ::: "memory");
    else asm volatile("s_waitcnt vmcnt(0) lgkmcnt(0)" ::: "memory");
    __builtin_amdgcn_s_barrier();
    __builtin_amdgcn_sched_barrier(0);
#pragma unroll
    for (int i = 0; i < 2; ++i)
#pragma unroll
      for (int j = 0; j < 2; ++j) acc[i][j] = MFMA(b0[j], a0[i], acc[i][j]);
#pragma unroll
    for (int i = 0; i < 2; ++i)
#pragma unroll
      for (int j = 0; j < 2; ++j) acc[i][j] = MFMA(b1[j], a1[i], acc[i][j]);
#pragma unroll
    for (int i = 0; i < 2; ++i)
#pragma unroll
      for (int j = 0; j < 2; ++j) acc[i][j] = MFMA(b2[j], a2[i], acc[i][j]);
#pragma unroll
    for (int i = 0; i < 2; ++i)
#pragma unroll
      for (int j = 0; j < 2; ++j) acc[i][j] = MFMA(b3[j], a3[i], acc[i][j]);
    __builtin_amdgcn_sched_barrier(0);
    __builtin_amdgcn_s_barrier();
    __builtin_amdgcn_sched_barrier(0);
    cur = cur == 4 * STG ? 0 : cur + 2 * STG;
    nxt = nxt == 4 * STG ? 0 : nxt + 2 * STG;
  }
  if (grp == 0) __builtin_amdgcn_s_barrier();
#undef DMA3
#pragma unroll
  for (int i = 0; i < 2; ++i)
#pragma unroll
    for (int j = 0; j < 2; ++j)
#pragma unroll
      for (int q = 0; q < 4; q += 2) {
        const int m = wm * 64 + i * 32 + l32, n = wn * 64 + j * 32 + 8 * q;
        const uint2 pa = epi(m, n + 4 * hh, acc[i][j][4 * q], acc[i][j][4 * q + 1], acc[i][j][4 * q + 2], acc[i][j][4 * q + 3]);
        const uint2 pb = epi(m, n + 8 + 4 * hh, acc[i][j][4 * q + 4], acc[i][j][4 * q + 5], acc[i][j][4 * q + 6], acc[i][j][4 * q + 7]);
        store_pair16(rowptr(m) + n, pa, pb, hh);
      }
}

template <class AF, class BF, class EF, class RF>
DI void gemm8w_m128(char* smem, int K, AF arow, BF brow, EF epi, RF rowptr) {
  constexpr int STG = 16384;
  const int tid = tidf_(), lane = tid & 63, wave = tid >> 6;
  const int grp = __builtin_amdgcn_readfirstlane(wave >> 2);
  const int wm = wave >> 1, wn = wave & 1, l32 = lane & 31, hh = lane >> 5;
  const int lr = lane >> 2, lc = ((lane & 3) ^ ((lane >> 4) & 3)) * 8;
  const f16* ap0 = arow(wave * 16 + lr) + lc;
  const f16* bp0 = brow(wave * 16 + lr) + lc;
  const int dA = wave * 1024 + lane * 16, dB = 8192 + wave * 1024 + lane * 16;
#define DMA3(stage_off, ko)                                                                                              \
  __builtin_amdgcn_global_load_lds((const void*)(ap0 + (ko)), (LAS void*)(smem + (stage_off) + dA), 16, 0, 0);          \
  __builtin_amdgcn_global_load_lds((const void*)(bp0 + (ko)), (LAS void*)(smem + (stage_off) + dB), 16, 0, 0);
  const int nk = K >> 5;
  DMA3(0, 0)
  DMA3(STG, 32)
  DMA3(2 * STG, 64)
  DMA3(3 * STG, 96)
  asm volatile("s_waitcnt vmcnt(4)" ::: "memory");
  __builtin_amdgcn_s_barrier();
  if (grp == 1) __builtin_amdgcn_s_barrier();
  f32x16 acc[1][2];
#pragma unroll
  for (int i = 0; i < 1; ++i)
#pragma unroll
    for (int j = 0; j < 2; ++j)
#pragma unroll
      for (int e = 0; e < 16; ++e) acc[i][j][e] = 0.f;
  const int rsw = (l32 >> 2) & 3;
  const int aoff = (wm * 32 + l32) * 64, boff = 8192 + (wn * 64 + l32) * 64;
  const int co0 = ((0 + hh) ^ rsw) << 4, co1 = ((2 + hh) ^ rsw) << 4;
  int cur = 0, nxt = 4 * STG;
  for (int kt = 0; kt < nk; kt += 2) {
    const char* st = smem + cur;
    f16x8 a0[1], b0[2], a1[1], b1[2], a2[1], b2[2], a3[1], b3[2];
#pragma unroll
    for (int j = 0; j < 2; ++j) { b0[j] = *(const f16x8*)(st + boff + j * 2048 + co0); b1[j] = *(const f16x8*)(st + boff + j * 2048 + co1); }
#pragma unroll
    for (int i = 0; i < 1; ++i) { a0[i] = *(const f16x8*)(st + aoff + i * 2048 + co0); a1[i] = *(const f16x8*)(st + aoff + i * 2048 + co1); }
#pragma unroll
    for (int j = 0; j < 2; ++j) { b2[j] = *(const f16x8*)(st + STG + boff + j * 2048 + co0); b3[j] = *(const f16x8*)(st + STG + boff + j * 2048 + co1); }
#pragma unroll
    for (int i = 0; i < 1; ++i) { a2[i] = *(const f16x8*)(st + STG + aoff + i * 2048 + co0); a3[i] = *(const f16x8*)(st + STG + aoff + i * 2048 + co1); }
    __builtin_amdgcn_sched_barrier(0);
    if (kt + 4 < nk) { DMA3(nxt, (kt + 4) * 32) DMA3(nxt + STG, (kt + 5) * 32) }
    __builtin_amdgcn_sched_barrier(0);
    if (kt + 4 < nk) asm volatile("s_waitcnt vmcnt(4) lgkmcnt(0)" ::: "memory");
    else asm volatile("s_waitcnt vmcnt(0) lgkmcnt(0)" ::: "memory");
    __builtin_amdgcn_s_barrier();
    __builtin_amdgcn_sched_barrier(0);
#pragma unroll
    for (int i = 0; i < 1; ++i)
#pragma unroll
      for (int j = 0; j < 2; ++j) acc[i][j] = MFMA(b0[j], a0[i], acc[i][j]);
#pragma unroll
    for (int i = 0; i < 1; ++i)
#pragma unroll
      for (int j = 0; j < 2; ++j) acc[i][j] = MFMA(b1[j], a1[i], acc[i][j]);
#pragma unroll
    for (int i = 0; i < 1; ++i)
#pragma unroll
      for (int j = 0; j < 2; ++j) acc[i][j] = MFMA(b2[j], a2[i], acc[i][j]);
#pragma unroll
    for (int i = 0; i < 1; ++i)
#pragma unroll
      for (int j = 0; j < 2; ++j) acc[i][j] = MFMA(b3[j], a3[i], acc[i][j]);
    __builtin_amdgcn_sched_barrier(0);
    __builtin_amdgcn_s_barrier();
    __builtin_amdgcn_sched_barrier(0);
    cur = cur == 4 * STG ? 0 : cur + 2 * STG;
    nxt = nxt == 4 * STG ? 0 : nxt + 2 * STG;
  }
  if (grp == 0) __builtin_amdgcn_s_barrier();
#undef DMA3
#pragma unroll
  for (int i = 0; i < 1; ++i)
#pragma unroll
    for (int j = 0; j < 2; ++j)
#pragma unroll
      for (int q = 0; q < 4; q += 2) {
        const int m = wm * 32 + i * 32 + l32, n = wn * 64 + j * 32 + 8 * q;
        const uint2 pa = epi(m, n + 4 * hh, acc[i][j][4 * q], acc[i][j][4 * q + 1], acc[i][j][4 * q + 2], acc[i][j][4 * q + 3]);
        const uint2 pb = epi(m, n + 8 + 4 * hh, acc[i][j][4 * q + 4], acc[i][j][4 * q + 5], acc[i][j][4 * q + 6], acc[i][j][4 * q + 7]);
        store_pair16(rowptr(m) + n, pa, pb, hh);
      }
}

DI uint2 pack4h(float a, float b, float c, float d) {
  f16x4 v;
  v[0] = (f16)a; v[1] = (f16)b; v[2] = (f16)c; v[3] = (f16)d;
  return __builtin_bit_cast(uint2, v);
}
DI void store_pair16(f16* dst, uint2 a, uint2 b, int hh) {
  const auto r0 = __builtin_amdgcn_permlane32_swap(a.x, b.x, false, false);
  const auto r1 = __builtin_amdgcn_permlane32_swap(a.y, b.y, false, false);
  uint4 o; o.x = r0[0]; o.y = r1[0]; o.z = r0[1]; o.w = r1[1];
  *(uint4*)(dst + 8 * hh) = o;
}
DI void store4h(f16* dst, float a, float b, float c, float d) {
  f16x4 v;
  v[0] = (f16)a; v[1] = (f16)b; v[2] = (f16)c; v[3] = (f16)d;
  *(f16x4*)dst = v;
}

DI void tconv_tile(char* smem, const float* src, int lds, f16* dst, int ldd, int k0, int n0) {
  float* t = (float*)smem;
  const int tid = tid_();
#pragma unroll
  for (int j = 0; j < 4; ++j) {
    const int r = (tid >> 4) + 16 * j, c4 = (tid & 15) * 4;
    const float4 v = *(const float4*)(src + (size_t)(k0 + r) * lds + n0 + c4);
    t[r * 65 + c4] = v.x; t[r * 65 + c4 + 1] = v.y; t[r * 65 + c4 + 2] = v.z; t[r * 65 + c4 + 3] = v.w;
  }
  __syncthreads();
  const int n = tid >> 2, kc = (tid & 3) * 16;
  f16x8 o0, o1;
#pragma unroll
  for (int i = 0; i < 8; ++i) { o0[i] = (f16)t[(kc + i) * 65 + n]; o1[i] = (f16)t[(kc + 8 + i) * 65 + n]; }
  f16* d = dst + (size_t)(n0 + n) * ldd + k0 + kc;
  *(f16x8*)d = o0;
  *(f16x8*)(d + 8) = o1;
  __syncthreads();
}

DI void ada_item(KP P, char* smem, int item) {
  const int tid = tid_(), lane = tid & 63, wave = tid >> 6;
  const int layer = item / 96, rem = item % 96, cb = rem >> 2, kc = rem & 3;
  float* sc = (float*)smem;
  float* red = (float*)smem + 1280;
  for (int i = tid; i < 1280; i += 256) {
    const int j = i >> 8, k = kc * 256 + (i & 255);
    const float v = j == 0 ? P->c_ctx[k] : P->c[(j - 1) * 1024 + k];
    sc[i] = v / (1.f + __expf(-v));
  }
  __syncthreads();
  float a[5][4];
#pragma unroll
  for (int j = 0; j < 5; ++j)
#pragma unroll
    for (int e = 0; e < 4; ++e) a[j][e] = 0.f;
  const float* w = P->ada_w + ((size_t)layer * 1024 + kc * 256 + wave * 64) * 6144 + cb * 256 + lane * 4;
#pragma unroll 8
  for (int i = 0; i < 64; ++i) {
    const float4 v = *(const float4*)(w + (size_t)i * 6144);
#pragma unroll
    for (int j = 0; j < 5; ++j) {
      const float s = sc[j * 256 + wave * 64 + i];
      a[j][0] += s * v.x; a[j][1] += s * v.y; a[j][2] += s * v.z; a[j][3] += s * v.w;
    }
  }
#pragma unroll
  for (int j = 0; j < 5; ++j)
#pragma unroll
    for (int e = 0; e < 4; ++e) red[(wave * 5 + j) * 256 + lane * 4 + e] = a[j][e];
  __syncthreads();
  float* adap = (float*)(P->ws + WS_ADAP);
#pragma unroll
  for (int j = 0; j < 5; ++j) {
    const float s = red[(0 * 5 + j) * 256 + tid] + red[(1 * 5 + j) * 256 + tid] + red[(2 * 5 + j) * 256 + tid] +
                    red[(3 * 5 + j) * 256 + tid];
    adap[((layer * 4 + kc) * 5 + j) * 6144 + cb * 256 + tid] = s;
  }
  __syncthreads();
}

DI void const_item(KP P, int item) {
  f16* fc = (f16*)(P->ws + WS_FC);
  f16* d256 = (f16*)(P->ws + WS_D256);
  f16* f64 = (f16*)(P->ws + WS_F64);
  f16* ds = (f16*)(P->ws + WS_DS);
#pragma unroll 1
  for (int j = 0; j < 8; ++j) {
    int e = item * 2048 + j * 256 + tid_();
    float sn, cs;
    if (e < 32768) {
      const int m = e >> 7, c = e & 127, l = m >> 1, ri = m & 1;
      sincospif((float)((l * c) & 127) * (1.f / 64.f), &sn, &cs);
      fc[e] = (f16)((ri ? -sn : cs) * 0.08838834764831845f);
    } else if (e < 32768 + 131072) {
      e -= 32768;
      const int k = e >> 9, col = e & 511, ri = col >> 8, s = col & 255;
      sincospif((float)((k * s) & 255) * (1.f / 128.f), &sn, &cs);
      d256[e] = (f16)((ri ? sn : cs) * 0.0625f);
    } else if (e < 32768 + 131072 + 16384) {
      e -= 32768 + 131072;
      const int n = e >> 7, col = e & 127, rip = n >> 6, k2 = n & 63, ri = col >> 6, s2 = col & 63;
      sincospif((float)((k2 * s2) & 63) * (1.f / 32.f), &sn, &cs);
      f64[e] = (f16)((rip == ri ? cs : (rip == 0 ? sn : -sn)) * 0.125f);
    } else {
      e -= 32768 + 131072 + 16384;
      const int k = e >> 7, col = e & 127, ri = col >> 6, s1 = col & 63;
      sincospif((float)((k * s1) & 4095) * (1.f / 2048.f), &sn, &cs);
      ds[e] = (f16)((ri ? sn : cs) * 0.125f);
    }
  }
}

DI void phase_prep(KP P, char* smem) {
  constexpr int NADA = 192, NTC = 5792, NCONST = 344;
  smem += half_() * kHalfLds;
  for (int it = blockIdx.x * 2 + half_(); it < NADA + NTC + NCONST; it += gridDim.x * 2) {
    if (it < NADA) {
      ada_item(P, smem, it);
    } else if (it < NADA + NTC) {
      int i = it - NADA;
      const float* src; f16* dst; int K, N;
      if (i < 384) { src = P->e_w_in; dst = (f16*)(P->ws + WS_WIN); K = 1024; N = 1536; }
      else if (i < 640) { i -= 384; src = P->e_w_out; dst = (f16*)(P->ws + WS_WOUT0); K = 1024; N = 1024; }
      else if (i < 2688) { i -= 640; const int l = i >> 10; i &= 1023; src = P->w1 + (size_t)l * 1024 * 4096; dst = (f16*)(P->ws + WS_W1) + (size_t)l * 4096 * 1024; K = 1024; N = 4096; }
      else if (i < 4736) { i -= 2688; const int l = i >> 10; i &= 1023; src = P->w2 + (size_t)l * 4096 * 1024; dst = (f16*)(P->ws + WS_W2) + (size_t)l * 1024 * 4096; K = 4096; N = 1024; }
      else if (i < 5504) { i -= 4736; src = P->o_w_qkv; dst = (f16*)(P->ws + WS_WQKV); K = 1024; N = 3072; }
      else if (i < 5760) { i -= 5504; src = P->o_w_out; dst = (f16*)(P->ws + WS_WO1); K = 1024; N = 1024; }
      else {
        i -= 5760;
        const int hb = i & 7, ri = (i >> 3) & 1, d = i >> 4;
        src = (ri ? P->e_w_i : P->e_w_r) + (size_t)(d * 8 + hb) * 4096;
        dst = (f16*)(P->ws + WS_GW) + (size_t)i * 4096;
        K = 64; N = 64; i = 0;
      }
      const int ntn = N >> 6;
      tconv_tile(smem, src, N, dst, K, (i / ntn) * 64, (i % ntn) * 64);
    } else {
      const_item(P, it - NADA - NTC);
    }
  }
}

#define DPP_ADD(v, ctrl) ((v) + __builtin_bit_cast(float, __builtin_amdgcn_update_dpp(0, __builtin_bit_cast(int, (v)), (ctrl), 0xF, 0xF, true)))
DI float wave_allsum_dpp(float v) {
  v = DPP_ADD(v, 0xB1);
  v = DPP_ADD(v, 0x4E);
  v = DPP_ADD(v, 0x141);
  v = DPP_ADD(v, 0x140);
  const unsigned u = __builtin_bit_cast(unsigned, v);
  const auto r16 = __builtin_amdgcn_permlane16_swap(u, u, false, false);
  v = __builtin_bit_cast(float, (unsigned)r16[0]) + __builtin_bit_cast(float, (unsigned)r16[1]);
  const unsigned w = __builtin_bit_cast(unsigned, v);
  const auto r32 = __builtin_amdgcn_permlane32_swap(w, w, false, false);
  return __builtin_bit_cast(float, (unsigned)r32[0]) + __builtin_bit_cast(float, (unsigned)r32[1]);
}
constexpr int LNB = 5;
DI void wave_sum_n(float (&s)[LNB]) {
#pragma unroll
  for (int o = 32; o; o >>= 1)
#pragma unroll
    for (int r = 0; r < LNB; ++r) s[r] += __shfl_xor(s[r], o);
}
DI void ln_stats(float (&v)[LNB][16], float (&rstd)[LNB]) {
  float s[LNB], s2[LNB];
#pragma unroll
  for (int r = 0; r < LNB; ++r) {
    s[r] = 0.f; s2[r] = 0.f;
#pragma unroll
    for (int k = 0; k < 16; ++k) { s[r] += v[r][k]; s2[r] = fmaf(v[r][k], v[r][k], s2[r]); }
  }
#pragma unroll
  for (int r = 0; r < LNB; ++r) { s[r] = wave_allsum_dpp(s[r]); s2[r] = wave_allsum_dpp(s2[r]); }
#pragma unroll
  for (int r = 0; r < LNB; ++r) {
    const float mean = s[r] * (1.f / 1024.f);
    const float var = fmaxf(s2[r] * (1.f / 1024.f) - mean * mean, 0.f);
    rstd[r] = rsqrtf(var + 1e-5f);
#pragma unroll
    for (int k = 0; k < 16; ++k) v[r][k] -= mean;
  }
}

template <bool SRC_INPUT, bool HAS_LN, bool HAS_MOD, bool DST_OUT>
DI void phase_ln(KP P, const float* g_, const float* b_, int layer, int shift_idx, int scale_idx) {
  const int tid = tidf_(), lane = tid & 63, wave = tid >> 6;
  if (SRC_INPUT) {
    const int e = blockIdx.x * 512 + tid;
    if (e < 2 * 5 * 6144) {
      const int layer_ = e / 30720, rem = e % 30720;
      ((float*)(P->ws + WS_ADAF))[e] = ada_val(P, layer_, rem / 6144, rem % 6144);
    }
  }
  f16* xr = (f16*)(P->ws + WS_XR);
  f16* hbuf = (f16*)(P->ws + WS_H);
  const int nw = gridDim.x * 8, rpw = (T + nw - 1) / nw;
  const int r_begin = (blockIdx.x * 8 + wave) * rpw, r_end = min(T, r_begin + rpw);
  float g[16], bb[16], sc[16], sh[16];
#pragma unroll
  for (int k = 0; k < 16; ++k) {
    const int col = (k >> 2) * 256 + lane * 4 + (k & 3);
    if (HAS_LN) { g[k] = g_[col]; bb[k] = b_[col]; } else { g[k] = 1.f; bb[k] = 0.f; }
    sc[k] = 1.f; sh[k] = 0.f;
  }
  int cur = -1;
#pragma unroll 1
  for (int t = r_begin; t < r_end; t += LNB) {
    float v[LNB][16], rstd[LNB];
#pragma unroll
    for (int r = 0; r < LNB; ++r) {
      const int tt = min(t + r, r_end - 1);
      if (SRC_INPUT) {
        const float* src = tt < TP ? P->x_prompt + (size_t)tt * 1024 : P->x_sample + (size_t)(tt - TP) * 1024;
#pragma unroll
        for (int j = 0; j < 4; ++j) {
          const float4 q = *(const float4*)(src + j * 256 + lane * 4);
          v[r][j * 4] = q.x; v[r][j * 4 + 1] = q.y; v[r][j * 4 + 2] = q.z; v[r][j * 4 + 3] = q.w;
        }
      } else {
#pragma unroll
        for (int j = 0; j < 4; ++j) {
          const f16x4 q = *(const f16x4*)(xr + (size_t)tt * 1024 + j * 256 + lane * 4);
          v[r][j * 4] = (float)q[0]; v[r][j * 4 + 1] = (float)q[1]; v[r][j * 4 + 2] = (float)q[2]; v[r][j * 4 + 3] = (float)q[3];
        }
      }
    }
    ln_stats(v, rstd);
    if (HAS_LN) {
#pragma unroll
      for (int r = 0; r < LNB; ++r) {
#pragma unroll
        for (int k = 0; k < 16; ++k) v[r][k] = v[r][k] * rstd[r] * g[k] + bb[k];
        if (t + r < r_end) {
          if (DST_OUT) {
            float* dst = P->out + (size_t)(t + r) * 1024;
#pragma unroll
            for (int j = 0; j < 4; ++j) {
              float4 q; q.x = v[r][j * 4]; q.y = v[r][j * 4 + 1]; q.z = v[r][j * 4 + 2]; q.w = v[r][j * 4 + 3];
              *(float4*)(dst + j * 256 + lane * 4) = q;
            }
          } else {
#pragma unroll
            for (int j = 0; j < 4; ++j)
              store4h(xr + (size_t)(t + r) * 1024 + j * 256 + lane * 4, v[r][j * 4], v[r][j * 4 + 1], v[r][j * 4 + 2], v[r][j * 4 + 3]);
          }
        }
      }
      if (HAS_MOD) ln_stats(v, rstd);
    }
    if (HAS_MOD) {
#pragma unroll
      for (int r = 0; r < LNB; ++r) {
        if (t + r < r_end) {
          const int cond = cond_of(t + r);
          if (cond != cur) {
            cur = cond;
#pragma unroll
            for (int k = 0; k < 16; ++k) {
              const int col = (k >> 2) * 256 + lane * 4 + (k & 3);
              sh[k] = SRC_INPUT ? ada_val(P, layer, cond, shift_idx * 1024 + col) : adaf(P, layer, cond, shift_idx * 1024 + col);
              sc[k] = 1.f + (SRC_INPUT ? ada_val(P, layer, cond, scale_idx * 1024 + col) : adaf(P, layer, cond, scale_idx * 1024 + col));
            }
          }
          f16* hd = hbuf + (size_t)(t + r) * 1024;
#pragma unroll
          for (int j = 0; j < 4; ++j)
            store4h(hd + j * 256 + lane * 4, v[r][j * 4] * rstd[r] * sc[j * 4] + sh[j * 4], v[r][j * 4 + 1] * rstd[r] * sc[j * 4 + 1] + sh[j * 4 + 1],
                    v[r][j * 4 + 2] * rstd[r] * sc[j * 4 + 2] + sh[j * 4 + 2], v[r][j * 4 + 3] * rstd[r] * sc[j * 4 + 3] + sh[j * 4 + 3]);
        }
      }
    }
  }
}

DI void scan_item(KP P, char* smem, int item, int mode) {
  const int tid = tid_(), lane = tid & 63, wave = tid >> 6, l32 = lane & 31, hh = lane >> 5;
  const int c = item >> 3, hb = item & 7;
  const int t0 = c * 64;
  const bool ctx = c < 64;
  const int bstart = ctx ? (c >> 2) * 256 : TP + ((c - 64) >> 6) * 4096;
  const int bend = bstart + (ctx ? 256 : 4096);
  const f16* u = (const f16*)(P->ws + WS_B1);
  float2* sum = (float2*)(P->ws + WS_SUM);
  float hcarry = 0.f;
  if (mode == 1) {
    const int cfirst = ctx ? (c & ~3) : 64 + ((c - 64) & ~63);
    const int clast = ctx ? (c | 3) : 64 + ((c - 64) | 63);
    const int nf = c - cfirst, nb = clast - c;
    float2* car = (float2*)smem;
    for (int idx = tid; idx < (nf + nb) * 64; idx += 256) {
      const int q = idx >> 6, nn = idx & 63;
      car[idx] = q < nf ? sum[(size_t)((cfirst + q) * 2) * 512 + hb * 64 + nn]
                        : sum[(size_t)((clast - (q - nf)) * 2 + 1) * 512 + hb * 64 + nn];
    }
    __syncthreads();
    if (tid < 128) {
      const int dd = tid >> 6, nn = tid & 63;
      const int lb = ctx ? 0 : ((c - 64) >> 6);
      float h = ctx ? 0.f : P->state_lru[(lb * 2 + dd) * 512 + hb * 64 + nn];
      const int q0 = dd ? nf : 0, q1 = dd ? nf + nb : nf;
#pragma unroll 4
      for (int q = q0; q < q1; ++q) { const float2 sv = car[q * 64 + nn]; h = sv.x * h + sv.y; }
      hcarry = h;
    }
    __syncthreads();
  }
  {
    const int tok = tid >> 2, cb = (tid & 3) * 16, t = t0 + tok, ch0 = hb * 64 + cb;
    float acc[16];
#pragma unroll
    for (int i = 0; i < 4; ++i) {
      const float4 q = *(const float4*)(P->e_conv_b + ch0 + 4 * i);
      acc[4 * i] = q.x; acc[4 * i + 1] = q.y; acc[4 * i + 2] = q.z; acc[4 * i + 3] = q.w;
    }
#pragma unroll
    for (int k = 0; k < 4; ++k) {
      const int tt = t + k - 2;
      if (tt >= bstart && tt < bend) {
        const f16x8 x0 = *(const f16x8*)(u + (size_t)tt * 1536 + ch0);
        const f16x8 x1 = *(const f16x8*)(u + (size_t)tt * 1536 + ch0 + 8);
        float xv[16];
#pragma unroll
        for (int i = 0; i < 8; ++i) { xv[i] = (float)x0[i]; xv[8 + i] = (float)x1[i]; }
#pragma unroll
        for (int i = 0; i < 4; ++i) {
          const float4 wq = *(const float4*)(P->e_conv_w + k * 512 + ch0 + 4 * i);
          acc[4 * i] += wq.x * xv[4 * i]; acc[4 * i + 1] += wq.y * xv[4 * i + 1];
          acc[4 * i + 2] += wq.z * xv[4 * i + 2]; acc[4 * i + 3] += wq.w * xv[4 * i + 3];
        }
      }
    }
    f16x8 o0, o1;
#pragma unroll
    for (int i = 0; i < 8; ++i) { o0[i] = (f16)acc[i]; o1[i] = (f16)acc[8 + i]; }
    *(f16x8*)(smem + tok * 144 + cb * 2) = o0;
    *(f16x8*)(smem + tok * 144 + cb * 2 + 16) = o1;
  }
  {
    const f16* gw = (const f16*)(P->ws + WS_GW);
#pragma unroll
    for (int i = 0; i < 8; ++i) {
      const int id = tid + 256 * i, mat = id >> 9, rem = id & 511, n = rem >> 3, ch = rem & 7;
      const uint4 v = *(const uint4*)(gw + (size_t)(mat * 8 + hb) * 4096 + n * 64 + ch * 8);
      *(uint4*)(smem + 9216 + mat * 9216 + n * 144 + ch * 16) = v;
    }
  }
  __syncthreads();
  const int d = wave >> 1, nh = wave & 1;
  const int n = nh * 32 + l32, ch = hb * 64 + n;
  f32x16 accr0, accr1, acci0, acci1;
#pragma unroll
  for (int i = 0; i < 16; ++i) { accr0[i] = 0.f; accr1[i] = 0.f; acci0[i] = 0.f; acci1[i] = 0.f; }
#pragma unroll
  for (int ks = 0; ks < 4; ++ks) {
    const int ko = (ks * 16 + hh * 8) * 2;
    const f16x8 a0 = *(const f16x8*)(smem + l32 * 144 + ko);
    const f16x8 a1 = *(const f16x8*)(smem + (32 + l32) * 144 + ko);
    const f16x8 br = *(const f16x8*)(smem + 9216 + (d * 2) * 9216 + n * 144 + ko);
    const f16x8 bi = *(const f16x8*)(smem + 9216 + (d * 2 + 1) * 9216 + n * 144 + ko);
    accr0 = MFMA(a0, br, accr0);
    accr1 = MFMA(a1, br, accr1);
    acci0 = MFMA(a0, bi, acci0);
    acci1 = MFMA(a1, bi, acci1);
  }
  float xcv0[16], xcv1[16];
#pragma unroll
  for (int r = 0; r < 16; ++r) {
    xcv0[r] = (float)*(const f16*)(smem + crow(r, hh) * 144 + n * 2);
    xcv1[r] = (float)*(const f16*)(smem + (32 + crow(r, hh)) * 144 + n * 2);
  }
  __syncthreads();
  {
    const float brv = P->e_b_r[d * 512 + ch], biv = P->e_b_i[d * 512 + ch];
    const float sp = log1pf(__expf(-P->e_lam[d * 512 + ch]));
    float* as = (float*)smem + d * 4096;
    float* bs = (float*)smem + 8192 + d * 4096;
#pragma unroll
    for (int r = 0; r < 16; ++r) {
      {
        const int tok = crow(r, hh);
        const float rr = sigmoidf_(accr0[r] + brv), ii = sigmoidf_(acci0[r] + biv);
        const float la = -8.f * rr * sp;
        const float av = __expf(la);
        as[tok * 64 + n] = av;
        bs[tok * 64 + n] = __builtin_amdgcn_sqrtf(fmaxf(fmaf(-av, av, 1.f), 0.f)) * ii * xcv0[r];
      }
      {
        const int tok = 32 + crow(r, hh);
        const float rr = sigmoidf_(accr1[r] + brv), ii = sigmoidf_(acci1[r] + biv);
        const float la = -8.f * rr * sp;
        const float av = __expf(la);
        as[tok * 64 + n] = av;
        bs[tok * 64 + n] = __builtin_amdgcn_sqrtf(fmaxf(fmaf(-av, av, 1.f), 0.f)) * ii * xcv1[r];
      }
    }
  }
  __syncthreads();
  if (tid < 128) {
    const int dd = tid >> 6, nn = tid & 63, cc_ = hb * 64 + nn;
    const float* as = (const float*)smem + dd * 4096 + nn;
    float* bs = (float*)smem + 8192 + dd * 4096 + nn;
    float h = hcarry, p = 1.f;
#pragma unroll 1
    for (int blk = 0; blk < 8; ++blk) {
      const int tb = dd ? 56 - blk * 8 : blk * 8;
      float av[8], bv[8];
#pragma unroll
      for (int i = 0; i < 8; ++i) { av[i] = as[(tb + i) * 64]; bv[i] = bs[(tb + i) * 64]; }
      if (dd == 0) {
#pragma unroll
        for (int i = 0; i < 8; ++i) { h = av[i] * h + bv[i]; p *= av[i]; bv[i] = h; }
      } else {
#pragma unroll
        for (int i = 7; i >= 0; --i) { h = av[i] * h + bv[i]; p *= av[i]; bv[i] = h; }
      }
      if (mode == 1) {
#pragma unroll
        for (int i = 0; i < 8; ++i) bs[(tb + i) * 64] = bv[i];
      }
    }
    if (mode == 0) {
      sum[(size_t)(c * 2 + dd) * 512 + cc_] = make_float2(p, h);
    } else if (ctx) {
      if (dd == 0 && (c & 3) == 3) P->out[OUT_LRU + ((c >> 2) * 2 + 0) * 512 + cc_] = h;
      if (dd == 1 && (c & 3) == 0) P->out[OUT_LRU + ((c >> 2) * 2 + 1) * 512 + cc_] = h;
    }
  }
  __syncthreads();
  if (mode == 1) {
    const int tok = tid >> 2, cb = (tid & 3) * 16, t = t0 + tok;
    const float* hf = (const float*)smem + 8192 + tok * 64 + cb;
    const float* hbw = hf + 4096;
    const f16x8 g0 = *(const f16x8*)(u + (size_t)t * 1536 + 512 + hb * 64 + cb);
    const f16x8 g1 = *(const f16x8*)(u + (size_t)t * 1536 + 512 + hb * 64 + cb + 8);
    f16x8 o0, o1;
#pragma unroll
    for (int i = 0; i < 8; ++i) {
      float x = (float)g0[i];
      float gl = x * sigmoidf_(1.5957691216057308f * (x + 0.044715f * x * x * x));
      o0[i] = (f16)((hf[i] + hbw[i]) * gl);
      x = (float)g1[i];
      gl = x * sigmoidf_(1.5957691216057308f * (x + 0.044715f * x * x * x));
      o1[i] = (f16)((hf[8 + i] + hbw[8 + i]) * gl);
    }
    f16* yc = (f16*)(P->ws + WS_H) + (size_t)t * 1024 + hb * 64 + cb;
    *(f16x8*)yc = o0;
    *(f16x8*)(yc + 8) = o1;
    __syncthreads();
  }
}

template <int MODE>
DI void attn_tile(const char* kb_, const char* vb_, const char* bt, const int (&bi0)[16], const int (&bi1)[16], const f16x8 q0,
                  const f16x8 q1, const f16x8 q2, const f16x8 q3, float& m, float& lsum, f32x16& o0, f32x16& o1, int l32, int hh, int rsw) {
#define LIVE0(r) (MODE != 2 || (r) >= 12)
#define LIVE1(r) (MODE != 1 || (r) < 4)
  f32x16 s0, s1;
#pragma unroll
  for (int i = 0; i < 16; ++i) { s0[i] = 0.f; s1[i] = 0.f; }
  {
    int co = ((0 + hh) ^ rsw) << 4;
    s0 = MFMA(*(const f16x8*)(kb_ + l32 * 128 + co), q0, s0);
    s1 = MFMA(*(const f16x8*)(kb_ + (32 + l32) * 128 + co), q0, s1);
    co = ((2 + hh) ^ rsw) << 4;
    s0 = MFMA(*(const f16x8*)(kb_ + l32 * 128 + co), q1, s0);
    s1 = MFMA(*(const f16x8*)(kb_ + (32 + l32) * 128 + co), q1, s1);
    co = ((4 + hh) ^ rsw) << 4;
    s0 = MFMA(*(const f16x8*)(kb_ + l32 * 128 + co), q2, s0);
    s1 = MFMA(*(const f16x8*)(kb_ + (32 + l32) * 128 + co), q2, s1);
    co = ((6 + hh) ^ rsw) << 4;
    s0 = MFMA(*(const f16x8*)(kb_ + l32 * 128 + co), q3, s0);
    s1 = MFMA(*(const f16x8*)(kb_ + (32 + l32) * 128 + co), q3, s1);
  }
  if (MODE != 0) {
#pragma unroll
    for (int r = 0; r < 16; ++r) {
      if (LIVE0(r)) s0[r] += *(const float*)(bt + bi0[r]);
      if (LIVE1(r)) s1[r] += *(const float*)(bt + bi1[r]);
    }
  }
  float mx = -INFINITY;
#pragma unroll
  for (int r = 0; r < 16; ++r) {
    if (LIVE0(r)) mx = fmaxf(mx, s0[r]);
    if (LIVE1(r)) mx = fmaxf(mx, s1[r]);
  }
  {
    const unsigned mu = __builtin_bit_cast(unsigned, mx);
    const auto mr = __builtin_amdgcn_permlane32_swap(mu, mu, false, false);
    mx = fmaxf(__builtin_bit_cast(float, (unsigned)mr[0]), __builtin_bit_cast(float, (unsigned)mr[1]));
  }
  const float mn = fmaxf(m, mx);
  const float alpha = __builtin_amdgcn_exp2f(m - mn);
  m = mn;
  float ps0 = 0.f, ps1 = 0.f;
#pragma unroll
  for (int r = 0; r < 16; ++r) {
    if (LIVE0(r)) { s0[r] = __builtin_amdgcn_exp2f(s0[r] - mn); ps0 += s0[r]; } else s0[r] = 0.f;
    if (LIVE1(r)) { s1[r] = __builtin_amdgcn_exp2f(s1[r] - mn); ps1 += s1[r]; } else s1[r] = 0.f;
  }
  lsum = lsum * alpha + (ps0 + ps1);
  if (__any(alpha != 1.f)) {
#pragma unroll
    for (int r = 0; r < 16; ++r) { o0[r] *= alpha; o1[r] *= alpha; }
  }
#pragma unroll
  for (int kb = 0; kb < 2; ++kb)
#pragma unroll
    for (int st = 0; st < 2; ++st) {
      if ((MODE == 1 && kb == 1 && st == 1) || (MODE == 2 && kb == 0 && st == 0)) continue;
      typedef __attribute__((ext_vector_type(2))) __fp16 h2_t;
      typedef __attribute__((ext_vector_type(4))) unsigned u4_t;
      u4_t pu;
#pragma unroll
      for (int e = 0; e < 4; ++e) {
        const h2_t hv = kb == 0 ? __builtin_amdgcn_cvt_pkrtz(s0[8 * st + 2 * e], s0[8 * st + 2 * e + 1])
                                : __builtin_amdgcn_cvt_pkrtz(s1[8 * st + 2 * e], s1[8 * st + 2 * e + 1]);
        pu[e] = __builtin_bit_cast(unsigned, hv);
      }
      const f16x8 pf = __builtin_bit_cast(f16x8, pu);
      const int c0 = ((4 * kb + 2 * st) ^ rsw) << 4, c1 = ((4 * kb + 2 * st + 1) ^ rsw) << 4;
      {
        const f16x4 lo = *(const f16x4*)(vb_ + l32 * 128 + c0 + 8 * hh);
        const f16x4 hi = *(const f16x4*)(vb_ + l32 * 128 + c1 + 8 * hh);
        const f16x8 va = __builtin_shufflevector(lo, hi, 0, 1, 2, 3, 4, 5, 6, 7);
        o0 = MFMA(va, pf, o0);
      }
      {
        const f16x4 lo = *(const f16x4*)(vb_ + (32 + l32) * 128 + c0 + 8 * hh);
        const f16x4 hi = *(const f16x4*)(vb_ + (32 + l32) * 128 + c1 + 8 * hh);
        const f16x8 va = __builtin_shufflevector(lo, hi, 0, 1, 2, 3, 4, 5, 6, 7);
        o1 = MFMA(va, pf, o1);
      }
    }
#undef LIVE0
#undef LIVE1
}

DI void attn_item(KP P, char* smem, int item) {
  constexpr int NS = 6, PD = 4;
  const int tid = tidf_(), lane = tid & 63, wave = tid >> 6, l32 = lane & 31, hh = lane >> 5;
  const int sub = wave >> 1, sw = wave & 1;
  float* rpbs = (float*)(smem + NS * 16384);
  const bool latent = item < 1024;
  const int sid = (latent ? item : item - 1024) * 4 + sub;
  const f16* qbuf = (const f16*)(P->ws + WS_B1);
  const f16* kbuf = qbuf + (size_t)T * 1024;
  const char* b2 = (const char*)P->out;
  int b, h, row = 0, rs = 0, qtok0, ntiles, nloc = 0, a0 = 0;
  if (latent) {
    b = sid >> 10; h = (sid >> 6) & 15; row = sid & 63; rs = min(max(row - 4, 0), 56); qtok0 = TP + b * 4096 + row * 64;
    const int r0 = row & ~3;
    a0 = min(max(r0 - 4, 0), 56);
    const int a1 = min(max(r0 - 1, 0), 56) + 7;
    nloc = a1 - a0 + 1; ntiles = nloc + 8;
  } else { b = sid >> 6; h = (sid >> 2) & 15; qtok0 = b * 256 + (sid & 3) * 64; ntiles = 4; }
  const int drow = wave * 8 + (lane >> 3), dch = ((lane & 7) ^ ((drow >> 1) & 7)) * 8;
  const int dlds = wave * 1024 + lane * 16;
  auto dma = [&](int j) {
    const f16 *kp, *vp; size_t kst, vst;
    if (latent) {
      if (j < nloc) {
        kp = kbuf + (size_t)(TP + b * 4096 + (a0 + j) * 64) * 1024 + h * 64; kst = 1024;
        vp = (const f16*)(b2 + B2_VTL) + (size_t)((b * 16 + h) * 64) * 4096 + (a0 + j) * 64; vst = 4096;
      } else {
        kp = (const f16*)(b2 + B2_CK) + (size_t)((b * 16 + h) * 512 + (j - nloc) * 64) * 64; kst = 64;
        vp = (const f16*)(b2 + B2_CVT) + (size_t)((b * 16 + h) * 64) * 512 + (j - nloc) * 64; vst = 512;
      }
    } else {
      kp = kbuf + (size_t)(b * 256 + j * 64) * 1024 + h * 64; kst = 1024;
      vp = (const f16*)(b2 + B2_VTC) + (size_t)((b * 16 + h) * 64) * 256 + j * 64; vst = 256;
    }
    char* st = smem + (j % NS) * 16384;
    __builtin_amdgcn_global_load_lds((const void*)(kp + (size_t)drow * kst + dch), (LAS void*)(st + dlds), 16, 0, 0);
    __builtin_amdgcn_global_load_lds((const void*)(vp + (size_t)drow * vst + dch), (LAS void*)(st + 8192 + dlds), 16, 0, 0);
  };
#pragma unroll
  for (int j = 0; j < PD; ++j) if (j < ntiles) dma(j);
  if (latent) for (int i = tid; i < 480; i += 512) { const int rr = i >> 5, cc = i & 31; rpbs[i] = cc < 31 ? P->o_rpb[h * 465 + rr * 31 + cc] * LOG2E : -INFINITY; }
  const int qc = sw * 32 + l32;
  const f16* qp = qbuf + (size_t)(qtok0 + qc) * 1024 + h * 64 + hh * 8;
  const f16x8 q0 = *(const f16x8*)qp, q1 = *(const f16x8*)(qp + 16), q2 = *(const f16x8*)(qp + 32), q3 = *(const f16x8*)(qp + 48);
  __syncthreads();
  float m = -INFINITY, lsum = 0.f;
  f32x16 o0, o1;
#pragma unroll
  for (int i = 0; i < 16; ++i) { o0[i] = 0.f; o1[i] = 0.f; }
  const int rsw = (l32 >> 1) & 7;
  const int cs = min(max(qc - 8, 0), 48);
  int bi0[16], bi1[16];
#pragma unroll
  for (int r = 0; r < 16; ++r) {
    const int k0 = crow(r, hh), k1 = 32 + k0;
    bi0[r] = ((k0 >= cs && k0 < cs + 16) ? (k0 - qc + 15) : 31) * 4;
    bi1[r] = ((k1 >= cs && k1 < cs + 16) ? (k1 - qc + 15) : 31) * 4;
  }
#pragma unroll 1
  for (int j = 0; j < ntiles; ++j) {
    if (j + PD < ntiles) dma(j + PD);
    {
      const int ahead = min(PD, ntiles - 1 - j);
      if (ahead >= 4) asm volatile("s_waitcnt vmcnt(8)" ::: "memory");
      else if (ahead == 3) asm volatile("s_waitcnt vmcnt(6)" ::: "memory");
      else if (ahead == 2) asm volatile("s_waitcnt vmcnt(4)" ::: "memory");
      else if (ahead == 1) asm volatile("s_waitcnt vmcnt(2)" ::: "memory");
      else asm volatile("s_waitcnt vmcnt(0)" ::: "memory");
    }
    __builtin_amdgcn_s_barrier();
    __builtin_amdgcn_sched_barrier(0);
    const char* kb_ = smem + (j % NS) * 16384;
    const char* vb_ = kb_ + 8192;
    const bool act = !latent || j >= nloc || (a0 + j >= rs && a0 + j <= rs + 7);
    if (act) {
      if (latent && j < nloc) {
        const char* bt = (const char*)rpbs + (a0 + j - row + 7) * 128;
        if (sw == 0) attn_tile<1>(kb_, vb_, bt, bi0, bi1, q0, q1, q2, q3, m, lsum, o0, o1, l32, hh, rsw);
        else attn_tile<2>(kb_, vb_, bt, bi0, bi1, q0, q1, q2, q3, m, lsum, o0, o1, l32, hh, rsw);
      } else {
        attn_tile<0>(kb_, vb_, nullptr, bi0, bi1, q0, q1, q2, q3, m, lsum, o0, o1, l32, hh, rsw);
      }
    }
  }
  __syncthreads();
  float inv;
  {
    const unsigned lu = __builtin_bit_cast(unsigned, lsum);
    const auto lr_ = __builtin_amdgcn_permlane32_swap(lu, lu, false, false);
    inv = 1.f / (__builtin_bit_cast(float, (unsigned)lr_[0]) + __builtin_bit_cast(float, (unsigned)lr_[1]));
  }
  f16* op = (f16*)(P->ws + WS_H) + (size_t)(qtok0 + qc) * 1024 + h * 64;
#pragma unroll
  for (int q = 0; q < 4; ++q) {
    store4h(op + 8 * q + 4 * hh, o0[4 * q] * inv, o0[4 * q + 1] * inv, o0[4 * q + 2] * inv, o0[4 * q + 3] * inv);
    store4h(op + 32 + 8 * q + 4 * hh, o1[4 * q] * inv, o1[4 * q + 1] * inv, o1[4 * q + 2] * inv, o1[4 * q + 3] * inv);
  }
}

struct TileIter {
  int lt, step, nt, x;
  DI TileIter(int NT) {
    nt = NT;
    if (gridDim.x == 256) { x = blockIdx.x & 7; lt = blockIdx.x >> 3; step = 32; }
    else { x = -1; lt = blockIdx.x; step = gridDim.x; }
  }
  DI bool valid() const { return lt < (x >= 0 ? 10 * nt : 80 * nt); }
  DI int tm() const { return x >= 0 ? x + 8 * (lt / nt) : lt / nt; }
  DI int tn() const { return lt % nt; }
  DI void next() { lt += step; }
};

DI void phase_gin(KP P, char* smem) {
  const f16* hb = (const f16*)(P->ws + WS_H);
  const f16* w = (const f16*)(P->ws + WS_WIN);
  f16* u = (f16*)(P->ws + WS_B1);
  for (TileIter ti(6); ti.valid(); ti.next()) {
    const int tm = ti.tm(), tn = ti.tn();
    gemm8w<256, true, true>(smem, 1024, [&](int r) { return hb + (size_t)(tm * 256 + r) * 1024; },
              [&](int r) { return w + (size_t)(tn * 256 + r) * 1024; },
              [&](int m, int n, float v0, float v1, float v2, float v3) {
                const float4 bias = *(const float4*)(P->e_b_in + tn * 256 + n);
                return pack4h(v0 + bias.x, v1 + bias.y, v2 + bias.z, v3 + bias.w);
              }, [&](int m) { return u + (size_t)(tm * 256 + m) * 1536 + tn * 256; });
  }
}

DI void g1_tile(KP P, char* smem, int tile) {
  const int g = tile & 3, nt = (tile >> 2) & 1, mt = tile >> 3;
  const f16* u = (const f16*)(P->ws + WS_B1);
  const f16* fc = (const f16*)(P->ws + WS_FC);
  char* b2 = (char*)P->out;
  gemm_tile<true>(smem, 128,
            [&](int r) {
              const int m = mt * 256 + r;
              int tok = m;
              if (m >= TP) { const int lm = m - TP; tok = TP + (lm & ~4095) + ((lm >> 6) & 63) + 64 * (lm & 63); }
              return u + (size_t)tok * 1536 + 1024 + g * 128;
            },
            [&](int r) { return fc + (size_t)(nt * 128 + r) * 128; },
            [&](int m_, int n_, float v0, float v1, float v2, float v3) {
              const int m = mt * 256 + m_, n = nt * 128 + n_, l = n >> 1;
              f16* d;
              size_t ls, rs_;
              if (m < TP) {
                const int b = m >> 8, s_ = m & 255;
                d = (f16*)(b2 + B2_W1C) + ((size_t)((b * 4 + g) * 128 + l) * 512 + s_); ls = 512; rs_ = 256;
              } else {
                const int lm = m - TP, b = lm >> 12, s1 = (lm >> 6) & 63, s2 = lm & 63;
                d = (f16*)(b2 + B2_W1L) + ((size_t)(((b * 4 + g) * 128 + l) * 64 + s1) * 128 + s2); ls = 64 * 128; rs_ = 64;
              }
              d[0] = (f16)v0; d[rs_] = (f16)v1; d[ls] = (f16)v2; d[ls + rs_] = (f16)v3;
            });
}

DI void ct1_tile(KP P, char* smem, int mt) {
  char* b2 = (char*)P->out;
  const f16* w1l = (const f16*)(b2 + B2_W1L);
  const f16* f64 = (const f16*)(P->ws + WS_F64);
  f16* z = (f16*)(b2 + B2_Z);
  gemm_tile<true>(smem, 128, [&](int r) { return w1l + (size_t)(mt * 256 + r) * 128; }, [&](int r) { return f64 + (size_t)r * 128; },
            [&](int m_, int n, float v0, float v1, float v2, float v3) {
              const int m = mt * 256 + m_, bgl = m >> 6, s1 = m & 63, rip = n >> 6, k2 = n & 63;
              f16* d = z + ((size_t)(k2 * 2048 + bgl) * 128 + rip * 64 + s1);
              constexpr size_t ks = 2048ull * 128;
              d[0] = (f16)v0; d[ks] = (f16)v1; d[2 * ks] = (f16)v2; d[3 * ks] = (f16)v3;
            });
}

DI void ctxdft_tile(KP P, char* smem, int tile) {
  const int nt = tile & 1, mt = tile >> 1;
  char* b2 = (char*)P->out;
  const f16* w1c = (const f16*)(b2 + B2_W1C);
  const f16* dm = (const f16*)(P->ws + WS_D256);
  f16* yc = (f16*)(P->ws + WS_H);
  gemm_tile<true>(smem, 512, [&](int r) { return w1c + (size_t)(mt * 256 + r) * 512; },
            [&](int r) { return dm + (size_t)(nt * 128 + r) * 512; },
            [&](int m_, int n_, float v0, float v1, float v2, float v3) {
              const int m = mt * 256 + m_, k = nt * 128 + n_, b = m >> 9, g = (m >> 7) & 3, l = m & 127;
              f16* d = yc + (size_t)(b * 256 + k) * 1024 + 512 + g * 128 + l;
              d[0] = (f16)v0; d[1024] = (f16)v1; d[2048] = (f16)v2; d[3072] = (f16)v3;
            });
}

DI void ct2_tile(KP P, char* smem, int tile) {
  const int k2 = tile >> 3, mt = tile & 7;
  char* b2 = (char*)P->out;
  const f16* z = (const f16*)(b2 + B2_Z);
  const f16* dsm = (const f16*)(P->ws + WS_DS);
  f16* yc = (f16*)(P->ws + WS_H);
  gemm_tile<true>(smem, 128, [&](int r) { return z + (size_t)(k2 * 2048 + mt * 256 + r) * 128; },
            [&](int r) { return dsm + (size_t)(64 * (r & 63) + k2) * 128; },
            [&](int m_, int n, float v0, float v1, float v2, float v3) {
              if (n < 64) {
                const int m = mt * 256 + m_, b = m >> 9, g = (m >> 7) & 3, l = m & 127, k = 64 * n + k2;
                f16* d = yc + (size_t)(TP + b * 4096 + k) * 1024 + 512 + g * 128 + l;
                constexpr size_t ks = 64ull * 1024;
                d[0] = (f16)v0; d[ks] = (f16)v1; d[2 * ks] = (f16)v2; d[3 * ks] = (f16)v3;
              }
            });
}

template <bool FROM_INPUT>
DI void phase_proj(KP P, char* smem, const f16* w, const float* bias_, int layer, int gate_idx) {
  const f16* a = (const f16*)(P->ws + WS_H);
  f16* xr = (f16*)(P->ws + WS_XR);
  auto epi_at = [&](int t, int col, float v0, float v1, float v2, float v3) {
    const int cond = cond_of(t);
    const float4 bias = *(const float4*)(bias_ + col);
    const float4 gt = *(const float4*)((const float*)(P->ws + WS_ADAF) + (layer * 5 + cond) * 6144 + gate_idx * 1024 + col);
    float4 x;
    if (FROM_INPUT) {
      x = *(const float4*)((t < TP ? P->x_prompt + (size_t)t * 1024 : P->x_sample + (size_t)(t - TP) * 1024) + col);
    } else {
      const f16x4 q = *(const f16x4*)(xr + (size_t)t * 1024 + col);
      x.x = (float)q[0]; x.y = (float)q[1]; x.z = (float)q[2]; x.w = (float)q[3];
    }
    return pack4h(ALPHA * x.x + gt.x * (v0 + bias.x), ALPHA * x.y + gt.y * (v1 + bias.y),
                  ALPHA * x.z + gt.z * (v2 + bias.z), ALPHA * x.w + gt.w * (v3 + bias.w));
  };
  auto full_tile = [&](int tm, int tn) {
    gemm8w_n128(smem, 1024, [&](int r) { return a + (size_t)(tm * 256 + r) * 1024; },
                [&](int r) { return w + (size_t)(tn * 128 + r) * 1024; },
                [&](int m, int n, float v0, float v1, float v2, float v3) { return epi_at(tm * 256 + m, tn * 128 + n, v0, v1, v2, v3); },
                [&](int m) { return xr + (size_t)(tm * 256 + m) * 1024 + tn * 128; });
  };
  if (gridDim.x == 256) {
    const int x = blockIdx.x & 7, li = blockIdx.x >> 3;
    for (int lt = li; lt < 64; lt += 32) full_tile(x + 8 * (lt >> 3), lt & 7);
    const int tm = x + 8 * (8 + (li >> 4)), tn = (li & 15) >> 1, r0 = tm * 256 + (li & 1) * 128;
    gemm8w_m128(smem, 1024, [&](int r) { return a + (size_t)(r0 + r) * 1024; }, [&](int r) { return w + (size_t)(tn * 128 + r) * 1024; },
                [&](int m, int n, float v0, float v1, float v2, float v3) { return epi_at(r0 + m, tn * 128 + n, v0, v1, v2, v3); },
                [&](int m) { return xr + (size_t)(r0 + m) * 1024 + tn * 128; });
  } else {
    for (TileIter ti(8); ti.valid(); ti.next()) full_tile(ti.tm(), ti.tn());
  }
}

DI void phase_mlp1(KP P, char* smem, int layer) {
  const f16* a = (const f16*)(P->ws + WS_H);
  const f16* w = (const f16*)(P->ws + WS_W1) + (size_t)layer * 4096 * 1024;
  const float* bias_ = P->b1 + layer * 4096;
  for (TileIter ti(16); ti.valid(); ti.next()) {
    const int tm = ti.tm(), tn = ti.tn();
    f16* hid = tm * 256 < TH ? (f16*)P->out + (size_t)(tm * 256) * 4096 : (f16*)(P->ws + WS_B1) + (size_t)(tm * 256 - TH) * 4096;
    gemm8w<256, true, true>(smem, 1024, [&](int r) { return a + (size_t)(tm * 256 + r) * 1024; },
              [&](int r) { return w + (size_t)(tn * 256 + r) * 1024; },
              [&](int m, int n, float v0, float v1, float v2, float v3) {
                const float4 bias = *(const float4*)(bias_ + tn * 256 + n);
                v0 = fmaxf(v0 + bias.x, 0.f); v1 = fmaxf(v1 + bias.y, 0.f); v2 = fmaxf(v2 + bias.z, 0.f); v3 = fmaxf(v3 + bias.w, 0.f);
                return pack4h(v0 * v0, v1 * v1, v2 * v2, v3 * v3);
              }, [&](int m) { return hid + (size_t)m * 4096 + tn * 256; });
  }
}

DI void phase_mlp2(KP P, char* smem, int layer) {
  const f16* w = (const f16*)(P->ws + WS_W2) + (size_t)layer * 1024 * 4096;
  const float* bias_ = P->b2 + layer * 1024;
  f16* xr = (f16*)(P->ws + WS_XR);
  auto epi_at = [&](int t, int col, float v0, float v1, float v2, float v3) {
    const int cond = cond_of(t);
    const float4 bias = *(const float4*)(bias_ + col);
    const float4 gt = *(const float4*)((const float*)(P->ws + WS_ADAF) + (layer * 5 + cond) * 6144 + 5 * 1024 + col);
    f16* d = xr + (size_t)t * 1024 + col;
    const f16x4 q = *(const f16x4*)d;
    return pack4h(ALPHA * (float)q[0] + gt.x * (v0 + bias.x), ALPHA * (float)q[1] + gt.y * (v1 + bias.y),
                  ALPHA * (float)q[2] + gt.z * (v2 + bias.z), ALPHA * (float)q[3] + gt.w * (v3 + bias.w));
  };
  auto hid_row = [&](int t) { return t < TH ? (const f16*)P->out + (size_t)t * 4096 : (const f16*)(P->ws + WS_B1) + (size_t)(t - TH) * 4096; };
  auto full_tile = [&](int tm, int tn) {
    const f16* hid = hid_row(tm * 256);
    gemm8w_n128(smem, 4096, [&](int r) { return hid + (size_t)r * 4096; }, [&](int r) { return w + (size_t)(tn * 128 + r) * 4096; },
                [&](int m, int n, float v0, float v1, float v2, float v3) { return epi_at(tm * 256 + m, tn * 128 + n, v0, v1, v2, v3); },
                [&](int m) { return xr + (size_t)(tm * 256 + m) * 1024 + tn * 128; });
  };
  if (gridDim.x == 256) {
    const int x = blockIdx.x & 7, li = blockIdx.x >> 3;
    for (int lt = li; lt < 64; lt += 32) full_tile(x + 8 * (lt >> 3), lt & 7);
    const int tm = x + 8 * (8 + (li >> 4)), tn = (li & 15) >> 1, r0 = tm * 256 + (li & 1) * 128;
    const f16* hid = hid_row(r0);
    gemm8w_m128(smem, 4096, [&](int r) { return hid + (size_t)r * 4096; }, [&](int r) { return w + (size_t)(tn * 128 + r) * 4096; },
                [&](int m, int n, float v0, float v1, float v2, float v3) { return epi_at(r0 + m, tn * 128 + n, v0, v1, v2, v3); },
                [&](int m) { return xr + (size_t)(r0 + m) * 1024 + tn * 128; });
  } else {
    for (TileIter ti(8); ti.valid(); ti.next()) full_tile(ti.tm(), ti.tn());
  }
}

DI void qkv_tile(KP P, char* smem, int tile) {
  const int tm = tile / 12, tn = tile % 12;
  const f16* a = (const f16*)(P->ws + WS_H);
  const f16* w = (const f16*)(P->ws + WS_WQKV);
  f16* qbuf = (f16*)(P->ws + WS_B1);
  f16* kbuf = qbuf + (size_t)T * 1024;
  char* b2 = (char*)P->out;
  if (tn < 8) {
    gemm8w<256, true, true>(smem, 1024, [&](int r) { return a + (size_t)(tm * 256 + r) * 1024; },
              [&](int r) { return w + (size_t)(tn * 256 + r) * 1024; },
              [&](int m, int n, float v0, float v1, float v2, float v3) {
                const int col = tn * 256 + n, t = tm * 256 + m;
                const float4 bias = *(const float4*)(P->o_b_qkv + col);
                v0 += bias.x; v1 += bias.y; v2 += bias.z; v3 += bias.w;
                if (col < 1024) return pack4h(v0 * QSCALE, v1 * QSCALE, v2 * QSCALE, v3 * QSCALE);
                const int cc = col - 1024;
                if (t < TP) {
                  const int b = t >> 8, s = t & 255, hd = cc >> 6, dd = cc & 63;
                  float4 o; o.x = v0; o.y = v1; o.z = v2; o.w = v3;
                  *(float4*)(P->out + OUT_NK + ((size_t)((b * 16 + hd) * 256 + s) * 64 + dd)) = o;
                }
                return pack4h(v0, v1, v2, v3);
              }, [&](int m) { return (tn < 4 ? qbuf + tn * 256 : kbuf + (tn - 4) * 256) + (size_t)(tm * 256 + m) * 1024; });
  } else {
    gemm8w<256, false>(smem, 1024, [&](int r) { return a + (size_t)(tm * 256 + r) * 1024; },
              [&](int r) { return w + (size_t)(tn * 256 + r) * 1024; },
              [&](int m, int n, float v0, float v1, float v2, float v3) {
                const int col = tn * 256 + n, t = tm * 256 + m;
                const float bias = P->o_b_qkv[col];
                v0 += bias; v1 += bias; v2 += bias; v3 += bias;
                const int cc = col - 2048, hd = cc >> 6, dd = cc & 63;
                if (t < TP) {
                  const int b = t >> 8, s = t & 255;
                  store4h((f16*)(b2 + B2_VTC) + ((size_t)((b * 16 + hd) * 64 + dd) * 256 + s), v0, v1, v2, v3);
                  float* o = P->out + OUT_NV + ((size_t)((b * 16 + hd) * 256 + s) * 64 + dd);
                  o[0] = v0; o[64] = v1; o[128] = v2; o[192] = v3;
                } else {
                  const int lt = t - TP, b = lt >> 12, s = lt & 4095;
                  store4h((f16*)(b2 + B2_VTL) + ((size_t)((b * 16 + hd) * 64 + dd) * 4096 + s), v0, v1, v2, v3);
                }
              });
  }
}

DI void phase_qkv(KP P, char* smem) {
  constexpr int NG = 80 * 12, NCK = 256, NCV = 512;
  char* b2 = (char*)P->out;
  for (TileIter ti(12); ti.valid(); ti.next()) qkv_tile(P, smem, ti.tm() * 12 + ti.tn());
  char* hsm = smem + half_() * kHalfLds;
  int it0 = blockIdx.x * 2 + half_(), itstep = gridDim.x * 2;
  if (gridDim.x == 256) {
    const int li = blockIdx.x >> 3;
    if (li >= 24) { it0 = (((li - 24) * 8 + (blockIdx.x & 7)) * 2) + half_(); itstep = 128; } else { it0 = NCK + NCV; }
  }
  for (int it = it0; it < NCK + NCV; it += itstep) {
    if (it < NCK) {
      const int i0 = it * 8192;
      f16* ck = (f16*)(b2 + B2_CK);
#pragma unroll
      for (int j = 0; j < 8; ++j) {
        const int e = i0 + (j * 256 + tid_()) * 4;
        const float4 v = *(const float4*)(P->cache_k + e);
        store4h(ck + e, v.x, v.y, v.z, v.w);
      }
    } else {
      const int i = it - NCK, bh = i >> 3, kt = i & 7;
      tconv_tile(hsm, P->cache_v + (size_t)bh * 512 * 64, 64, (f16*)(b2 + B2_CVT) + (size_t)bh * 64 * 512, 512, kt * 64, 0);
    }
  }
}

#define XB_TMO      128
#define XB_XCNT(j)  (256  + 64 * (j))
#define XB_XSUB(j)  (1280 + 64 * (j))
#define XB_XGEN(j)  (2304 + 64 * (j))
#define XB_TOP      3328
#define XB_TOPGEN   3392
#define XCD_BAR_WORDS 3456
#define XB_SPIN_CAP (1u << 18)
DI unsigned xb_ld(unsigned* p) { return __hip_atomic_load(p, __ATOMIC_RELAXED, __HIP_MEMORY_SCOPE_AGENT); }
DI unsigned xb_add(unsigned* p, unsigned v) { return __hip_atomic_fetch_add(p, v, __ATOMIC_RELAXED, __HIP_MEMORY_SCOPE_AGENT); }
DI unsigned xb_xcc_id() { return (unsigned)__builtin_amdgcn_s_getreg((3 << 11) | 20) & 0xFu; }
#define XB_SPIN(cond, bar) do { unsigned _sp = 0; while (cond) { __builtin_amdgcn_s_sleep(1); \
    if ((++_sp & 255u) == 0u) { if (xb_ld(&(bar)[XB_TMO])) break; if (_sp > XB_SPIN_CAP) { atomicAdd(&(bar)[XB_TMO], 1u); break; } } } } while (0)
struct XcdBarrier { unsigned* bar; unsigned x; volatile LAS unsigned* st; };
DI XcdBarrier xcd_barrier_post(unsigned* bar, volatile LAS unsigned* st) {
  XcdBarrier b; b.bar = bar; b.x = xb_xcc_id(); b.st = st;
  if (threadIdx.x == 0) (void)xb_add(&bar[XB_XCNT(b.x)], 1u);
  return b;
}
DI void xcd_barrier_complete(unsigned* bar, unsigned x, unsigned& nloc, unsigned& nx) {
  const unsigned G = gridDim.x * gridDim.y * gridDim.z;
  unsigned sum, cnt, mine, sp = 0u;
  for (;;) {
    sum = 0u; cnt = 0u; mine = 0u;
#pragma unroll
    for (unsigned j = 0; j < 16; ++j) { const unsigned c = xb_ld(&bar[XB_XCNT(j)]); sum += c; cnt += (c > 0u) ? 1u : 0u; mine = (j == x) ? c : mine; }
    if (sum == G) break;
    __builtin_amdgcn_s_sleep(1);
    if ((++sp & 255u) == 0u) { if (xb_ld(&bar[XB_TMO])) break; if (sp > XB_SPIN_CAP) { atomicAdd(&bar[XB_TMO], 1u); break; } }
  }
  nloc = mine > 0u ? mine : 1u; nx = cnt > 0u ? cnt : 1u;
}
DI void xcd_barrier(const XcdBarrier& b) {
  asm volatile("s_waitcnt vmcnt(0)" ::: "memory");
  __syncthreads();
  if (threadIdx.x == 0) {
    unsigned* bar = b.bar;
    __builtin_amdgcn_s_waitcnt(0);
    unsigned nloc = b.st[0], nx = b.st[1];
    if (nloc == 0u) { xcd_barrier_complete(bar, b.x, nloc, nx); b.st[0] = nloc; b.st[1] = nx; }
    const unsigned old = xb_add(&bar[XB_XSUB(b.x)], 1u);
    const unsigned gen = old / nloc;
    if (old + 1u == (gen + 1u) * nloc) {
      __builtin_amdgcn_fence(__ATOMIC_RELEASE, "agent");
      asm volatile("s_waitcnt vmcnt(0)" ::: "memory");
      const unsigned og = xb_add(&bar[XB_TOP], 1u);
      const unsigned tg = og / nx;
      if (og + 1u == (tg + 1u) * nx) xb_add(&bar[XB_TOPGEN], 1u);
      else XB_SPIN(xb_ld(&bar[XB_TOPGEN]) == tg, bar);
      __builtin_amdgcn_fence(__ATOMIC_ACQUIRE, "agent");
      xb_add(&bar[XB_XGEN(b.x)], 1u);
      asm volatile("s_waitcnt vmcnt(0)" ::: "memory");
    } else {
      XB_SPIN(xb_ld(&bar[XB_XGEN(b.x)]) == gen, bar);
      __builtin_amdgcn_fence(__ATOMIC_ACQUIRE, "agent");
      asm volatile("s_waitcnt vmcnt(0)" ::: "memory");
    }
  }
  __syncthreads();
}

enum { PH_PREP = 0, PH_LN0, PH_GIN, PH_SCAN0, PH_SCAN1, PH_CT2, PH_OUT0, PH_LN1, PH_MLP1A, PH_MLP2A, PH_LN2, PH_QKV, PH_ATT,
       PH_OUT1, PH_LN3, PH_MLP1B, PH_MLP2B, PH_LN4, NPH };

__global__ void __launch_bounds__(512, 2) mk(Params PP) {
  extern __shared__ __attribute__((aligned(16))) char smem[];
  cg::grid_group grid = cg::this_grid();
  __shared__ uint4 xb_words;
  if (threadIdx.x == 0) xb_words = make_uint4(0u, 0u, 0u, 0u);
  __syncthreads();
  const XcdBarrier xb = xcd_barrier_post((unsigned*)(PP.ws + WS_BAR), (volatile LAS unsigned*)&xb_words);
  const int phase_hi = PP.phase_hi;
  if (phase_hi > 1000) grid.sync();
  for (int ph = PP.phase_lo; ph < phase_hi; ++ph) {
   const int reps = (ph == REP_PHASE) ? 2 : 1;
   for (int rep = 0; rep < reps; ++rep) {
    KP P = (KP)__builtin_amdgcn_kernarg_segment_ptr();
    asm volatile("" : "+s"(P));
    switch (ph) {
      case PH_PREP: phase_prep(P, smem); break;
      case PH_LN0: phase_ln<true, false, true, false>(P, nullptr, nullptr, 0, 0, 1); break;
      case PH_GIN: phase_gin(P, smem); break;
      case PH_SCAN0:
        for (int it = blockIdx.x * 2 + half_(); it < 2560 + 640; it += gridDim.x * 2) {
          char* hsm = smem + half_() * kHalfLds;
          if (it < 2560) scan_item(P, hsm, it, 0); else g1_tile(P, hsm, it - 2560);
        }
        break;
      case PH_SCAN1:
        for (int it = blockIdx.x * 2 + half_(); it < 64 + 2560 + 512; it += gridDim.x * 2) {
          char* hsm = smem + half_() * kHalfLds;
          if (it < 64) ctxdft_tile(P, hsm, it);
          else if (it < 64 + 2560) scan_item(P, hsm, it - 64, 1);
          else ct1_tile(P, hsm, it - 64 - 2560);
        }
        break;
      case PH_CT2:
        for (int it = blockIdx.x * 2 + half_(); it < 512; it += gridDim.x * 2) ct2_tile(P, smem + half_() * kHalfLds, it);
        break;
      case PH_OUT0: phase_proj<true>(P, smem, (const f16*)(P->ws + WS_WOUT0), P->e_b_out, 0, 2); break;
      case PH_LN1: phase_ln<false, true, true, false>(P, P->ln1_g, P->ln1_b, 0, 3, 4); break;
      case PH_MLP1A: phase_mlp1(P, smem, 0); break;
      case PH_MLP2A: phase_mlp2(P, smem, 0); break;
      case PH_LN2: phase_ln<false, true, true, false>(P, P->ln2_g, P->ln2_b, 1, 0, 1); break;
      case PH_QKV: phase_qkv(P, smem); break;
      case PH_ATT:
        for (int it = blockIdx.x; it < 1280; it += gridDim.x) {
          int item = it;
          if (it < 1024 && gridDim.x == 256) {
            const int x = blockIdx.x & 7, li = blockIdx.x >> 3, r = it >> 8;
            item = (r * 16 + 2 * x + (li >> 4)) * 16 + (li & 15);
          }
          attn_item(P, smem, item);
        }
        break;
      case PH_OUT1: phase_proj<false>(P, smem, (const f16*)(P->ws + WS_WO1), P->o_b_out, 1, 2); break;
      case PH_LN3: phase_ln<false, true, true, false>(P, P->ln1_g + 1024, P->ln1_b + 1024, 1, 3, 4); break;
      case PH_MLP1B: phase_mlp1(P, smem, 1); break;
      case PH_MLP2B: phase_mlp2(P, smem, 1); break;
      case PH_LN4: phase_ln<false, true, false, true>(P, P->ln2_g + 1024, P->ln2_b + 1024, 1, 0, 0); break;
    }
    if (ph + 1 < phase_hi || rep + 1 < reps) xcd_barrier(xb);
   }
  }
}

extern "C" void kernel_launch(void* const* d_in, const int* in_sizes, int n_in, void* d_out, int out_size, void* d_ws,
                              size_t ws_size, hipStream_t stream) {
  static int grid_blocks = 0;
  if (!grid_blocks) {
    hipFuncSetAttribute((const void*)mk, hipFuncAttributeMaxDynamicSharedMemorySize, kLds);
    int dev = 0, cus = 0, per_cu = 0;
    hipGetDevice(&dev);
    hipDeviceGetAttribute(&cus, hipDeviceAttributeMultiprocessorCount, dev);
    hipOccupancyMaxActiveBlocksPerMultiprocessor(&per_cu, mk, 512, kLds);
    if (per_cu > 1) per_cu = 1;
    grid_blocks = cus * per_cu;
  }
  Params p{};
  const float** pp = (const float**)&p;
  for (int i = 0; i < 33; ++i) pp[i] = (const float*)d_in[i];
  p.out = (float*)d_out;
  p.ws = (char*)d_ws;
  p.phase_lo = 0;
  p.phase_hi = NPH;
  if (ws_size < WS_END) { fprintf(stderr, "workspace too small: %zu < %zu\n", ws_size, (size_t)WS_END); return; }
  hipMemsetAsync((char*)d_ws + WS_BAR, 0, XCD_BAR_WORDS * 4, stream);
  void* args[] = {&p};
  hipError_t e = hipLaunchCooperativeKernel((const void*)mk, dim3(grid_blocks), dim3(512), args, kLds, stream);
  if (e != hipSuccess) fprintf(stderr, "cooperative launch failed: %s (grid %d)\n", hipGetErrorString(e), grid_blocks);
}
```
